# Optimizing an MI355X kernel written in HIP

```python
import jax, jax.numpy as jnp
from jax import lax
import numpy as np

D_MODEL = 2048
BATCH = 1
SEQ = 16384
DEPTH = 1

SSD_HEADS = 32
SSD_HEAD_DIM = 64
SSD_D_INNER = SSD_HEADS * SSD_HEAD_DIM
SSD_GROUPS = 4
SSD_D_STATE = 128
SSD_CONV = 4
SSD_CHUNK = 256
SSD_CONV_DIM = SSD_D_INNER + 2 * SSD_GROUPS * SSD_D_STATE
ATTN_HEADS = 16
ATTN_HEAD_DIM = 64
ATTN_D = ATTN_HEADS * ATTN_HEAD_DIM
DILATED_PATTERNS = ((128, 1), (512, 4), (2048, 16))
ATTN_BLOCK = 128
ROPE_DIM = ATTN_HEAD_DIM // 4
ROPE_THETA = 500000.0
D_MIX = SSD_D_INNER + ATTN_D
PROJ_SIZES = (SSD_D_INNER, SSD_D_INNER, SSD_GROUPS * SSD_D_STATE, SSD_GROUPS * SSD_D_STATE,
              SSD_HEADS, ATTN_D, ATTN_D, ATTN_D)
PROJ_DIM = sum(PROJ_SIZES)
PROJ_SPLITS = tuple(int(s) for s in np.cumsum(PROJ_SIZES)[:-1])
N_EXPERT_GROUPS = 8
EXPERTS_PER_GROUP = 8
N_EXPERTS = N_EXPERT_GROUPS * EXPERTS_PER_GROUP
TOP_K_IN_GROUP = 2
D_EXPERT = 1024
MOE_BLOCK = 128
EPS = 1e-6

kernel_name = "hymba_ssd_dilated_hiermoe_layer"


def _round_up(n, m):
    return (n + m - 1) // m * m


def rmsnorm(x, w):
    xf = x.astype(jnp.float32)
    y = xf * lax.rsqrt(jnp.mean(xf * xf, axis=-1, keepdims=True) + EPS)
    return (y * w.astype(jnp.float32)).astype(x.dtype)


def causal_depthwise_conv(u, w, b):
    c = u.shape[-1]
    y = lax.conv_general_dilated(u, w[:, None, :].astype(u.dtype), window_strides=(1,),
                                 padding=[(SSD_CONV - 1, 0)],
                                 dimension_numbers=("NWC", "WIO", "NWC"),
                                 feature_group_count=c)
    return y + b.astype(u.dtype)


def ssd_chunked(xh, dt, A, Bm, Cm):
    b, s = xh.shape[:2]
    L = _round_up(s, SSD_CHUNK)
    pad = L - s
    xh = jnp.pad(xh, ((0, 0), (0, pad), (0, 0), (0, 0)))
    dt = jnp.pad(dt, ((0, 0), (0, pad), (0, 0)))
    Bm = jnp.pad(Bm, ((0, 0), (0, pad), (0, 0), (0, 0)))
    Cm = jnp.pad(Cm, ((0, 0), (0, pad), (0, 0), (0, 0)))
    c = L // SSD_CHUNK
    E = SSD_HEADS // SSD_GROUPS
    x = xh.reshape(b, c, SSD_CHUNK, SSD_GROUPS, E, SSD_HEAD_DIM)
    dtc = dt.reshape(b, c, SSD_CHUNK, SSD_GROUPS, E)
    Bc = Bm.reshape(b, c, SSD_CHUNK, SSD_GROUPS, SSD_D_STATE)
    Cc = Cm.reshape(b, c, SSD_CHUNK, SSD_GROUPS, SSD_D_STATE)
    a = (dtc * A.reshape(SSD_GROUPS, E)).transpose(0, 1, 3, 4, 2)
    cs = jnp.cumsum(a, axis=-1)
    xdt = x * dtc[..., None]
    seg = cs[..., :, None] - cs[..., None, :]
    causal = jnp.tril(jnp.ones((SSD_CHUNK, SSD_CHUNK), dtype=bool))
    Lmat = jnp.exp(jnp.where(causal, seg, -jnp.inf))
    CB = jnp.einsum("bclgn,bcsgn->bcgls", Cc, Bc)
    y_diag = jnp.einsum("bcgls,bcgels,bcsgep->bclgep", CB, Lmat, xdt)
    decay_states = jnp.exp(cs[..., -1:] - cs)
    states = jnp.einsum("bcsgn,bcges,bcsgep->bcgepn", Bc, decay_states, xdt)
    chunk_decay = jnp.exp(cs[..., -1])

    def step(hstate, inp):
        st, dec = inp
        return hstate * dec[..., None, None] + st, hstate

    h0 = jnp.zeros((b, SSD_GROUPS, E, SSD_HEAD_DIM, SSD_D_STATE), xh.dtype)
    _, prev = lax.scan(step, h0, (jnp.moveaxis(states, 1, 0), jnp.moveaxis(chunk_decay, 1, 0)))
    prev = jnp.moveaxis(prev, 0, 1)
    y_off = jnp.einsum("bclgn,bcgepn,bcgel->bclgep", Cc, prev, jnp.exp(cs))
    y = (y_diag + y_off).reshape(b, L, SSD_HEADS, SSD_HEAD_DIM)
    return y[:, :s]


def partial_rotary(t, positions):
    half = ROPE_DIM // 2
    inv_freq = 1.0 / (ROPE_THETA ** (jnp.arange(0, ROPE_DIM, 2, dtype=jnp.float32) / ROPE_DIM))
    ang = positions.astype(jnp.float32)[..., None] * inv_freq
    cos = jnp.cos(ang)[:, :, None, :]
    sin = jnp.sin(ang)[:, :, None, :]
    t1 = t[..., :half].astype(jnp.float32)
    t2 = t[..., half:ROPE_DIM].astype(jnp.float32)
    rot = jnp.concatenate([t1 * cos - t2 * sin, t2 * cos + t1 * sin], axis=-1).astype(t.dtype)
    return jnp.concatenate([rot, t[..., ROPE_DIM:]], axis=-1)


def dilated_branch(q, k, v, window, dilation):
    b, s, h, hd = q.shape
    span = window // dilation
    blk = ATTN_BLOCK
    L = _round_up(s, dilation * blk)
    n = L // dilation
    nb = n // blk

    def to_blocks(t):
        t = jnp.pad(t.astype(jnp.float32), ((0, 0), (0, L - s), (0, 0), (0, 0)))
        t = t.reshape(b, n, dilation, h, hd).transpose(0, 3, 2, 1, 4)
        return t.reshape(b, h, dilation, nb, blk, hd)

    def with_prev(t):
        prev = jnp.pad(t, ((0, 0), (0, 0), (0, 0), (1, 0), (0, 0), (0, 0)))[:, :, :, :-1]
        return jnp.concatenate([prev, t], axis=4)

    qb = to_blocks(q)
    kk = with_prev(to_blocks(k))
    vv = with_prev(to_blocks(v))
    sc = jnp.einsum("bhrnqd,bhrnkd->bhrnqk", qb, kk) * (ATTN_HEAD_DIM ** -0.5)
    qi = jnp.arange(blk)[:, None] + blk
    kj = jnp.arange(2 * blk)[None, :]
    dist = qi - kj
    band = (dist >= 0) & (dist <= span)
    key_idx = jnp.arange(nb)[:, None] * blk + jnp.arange(2 * blk)[None, :] - blk
    valid = band[None] & (key_idx >= 0)[:, None, :]
    sc = jnp.where(valid, sc, -jnp.inf)
    m = jnp.max(sc, axis=-1)
    p = jnp.exp(sc - m[..., None])
    l = jnp.sum(p, axis=-1)
    o = jnp.einsum("bhrnqk,bhrnkd->bhrnqd", p, vv)
    o = o.reshape(b, h, dilation, n, hd).transpose(0, 3, 2, 1, 4).reshape(b, L, h, hd)[:, :s]
    m = m.reshape(b, h, dilation, n).transpose(0, 3, 2, 1).reshape(b, L, h)[:, :s]
    l = l.reshape(b, h, dilation, n).transpose(0, 3, 2, 1).reshape(b, L, h)[:, :s]
    return o, m, l


def dilated_mixture_attention(q, k, v):
    outs, ms, ls = [], [], []
    for window, dilation in DILATED_PATTERNS:
        o, m, l = dilated_branch(q, k, v, window, dilation)
        outs.append(o); ms.append(m); ls.append(l)
    ms = jnp.stack(ms)
    M = jnp.max(ms, axis=0)
    wts = jnp.exp(ms - M[None])
    num = jnp.sum(wts[..., None] * jnp.stack(outs), axis=0)
    den = jnp.sum(wts * jnp.stack(ls), axis=0)
    return (num / den[..., None]).astype(q.dtype)


def hierarchical_moe(t, layer, w_group_router, b_group_router, w_expert_router, b_expert_router,
                     w_gate, w_up, w_down):
    T, d = t.shape
    g_logits = jnp.dot(t, w_group_router[layer]).astype(jnp.float32) + b_group_router[layer]
    g_prob = jax.nn.softmax(g_logits, axis=-1)
    g_val, g_idx = lax.top_k(g_prob, 1)
    e_all = jnp.einsum("td,gde->tge", t, w_expert_router[layer]).astype(jnp.float32) + b_expert_router[layer]
    e_logits = jnp.take_along_axis(e_all, g_idx[:, :, None], axis=1)[:, 0]
    e_prob = jax.nn.softmax(e_logits, axis=-1)
    e_val, e_idx = lax.top_k(e_prob, TOP_K_IN_GROUP)
    e_val = e_val / jnp.sum(e_val, axis=-1, keepdims=True)
    gates = g_val * e_val
    expert_ids = g_idx * EXPERTS_PER_GROUP + e_idx

    A = T * TOP_K_IN_GROUP
    flat_e = expert_ids.reshape(-1)
    flat_tok = jnp.repeat(jnp.arange(T, dtype=jnp.int32), TOP_K_IN_GROUP)
    flat_w = gates.reshape(-1)
    order = jnp.argsort(flat_e)
    se, stok, sw = flat_e[order], flat_tok[order], flat_w[order]
    counts = jnp.bincount(flat_e, length=N_EXPERTS)
    padded = (counts + MOE_BLOCK - 1) // MOE_BLOCK * MOE_BLOCK
    off = jnp.cumsum(counts) - counts
    pend = jnp.cumsum(padded)
    poff = pend - padded
    dest = poff[se] + jnp.arange(A) - off[se]
    R = _round_up(A + N_EXPERTS * (MOE_BLOCK - 1), MOE_BLOCK)
    NB = R // MOE_BLOCK
    row_tok = jnp.full((R,), T, dtype=jnp.int32).at[dest].set(stok)
    t_pad = jnp.concatenate([t, jnp.zeros((1, d), t.dtype)], axis=0)
    x_rows = t_pad[row_tok].reshape(NB, MOE_BLOCK, d)
    block_start = jnp.arange(NB) * MOE_BLOCK
    block_exp = jnp.minimum(jnp.searchsorted(pend, block_start, side="right"), N_EXPERTS - 1)

    def expert_block(args):
        xb, e = args
        hid = jax.nn.silu(xb @ w_gate[layer, e]) * (xb @ w_up[layer, e])
        return hid @ w_down[layer, e]

    y_rows = lax.map(expert_block, (x_rows, block_exp)).reshape(R, d)
    y_assign = y_rows[dest] * sw[:, None].astype(y_rows.dtype)
    return jax.ops.segment_sum(y_assign, stok, num_segments=T)


def setup_inputs(seed: int = 0) -> dict:
    key = jax.random.key(seed)
    ks = jax.random.split(key, 24)
    f32 = jnp.float32

    def nrm(k, shape, scale):
        return jax.random.normal(k, shape, f32) * scale

    x = nrm(ks[0], (BATCH, SEQ, D_MODEL), 1.0)
    positions = jnp.tile(jnp.arange(SEQ, dtype=jnp.int32)[None, :], (BATCH, 1))
    norm1_w = 1.0 + nrm(ks[1], (DEPTH, D_MODEL), 0.02)
    w_in = nrm(ks[2], (DEPTH, D_MODEL, PROJ_DIM), D_MODEL ** -0.5)
    conv_w = nrm(ks[3], (DEPTH, SSD_CONV, SSD_CONV_DIM), SSD_CONV ** -0.5)
    conv_b = nrm(ks[4], (DEPTH, SSD_CONV_DIM), 0.01)
    u = jax.random.uniform(ks[5], (DEPTH, SSD_HEADS), f32)
    dt0 = jnp.exp(jnp.log(1e-3) + u * (jnp.log(1e-1) - jnp.log(1e-3)))
    dt_bias = dt0 + jnp.log(-jnp.expm1(-dt0))
    A_log = jnp.log(jax.random.uniform(ks[6], (DEPTH, SSD_HEADS), f32, 1.0, 16.0))
    D_skip = 1.0 + nrm(ks[7], (DEPTH, SSD_HEADS), 0.1)
    ssd_norm_w = 1.0 + nrm(ks[8], (DEPTH, SSD_D_INNER), 0.02)
    q_norm_w = 1.0 + nrm(ks[9], (DEPTH, ATTN_HEAD_DIM), 0.02)
    k_norm_w = 1.0 + nrm(ks[10], (DEPTH, ATTN_HEAD_DIM), 0.02)
    w_out = nrm(ks[11], (DEPTH, D_MIX, D_MODEL), D_MIX ** -0.5)
    norm2_w = 1.0 + nrm(ks[12], (DEPTH, D_MODEL), 0.02)
    w_group_router = nrm(ks[13], (DEPTH, D_MODEL, N_EXPERT_GROUPS), D_MODEL ** -0.5)
    b_group_router = nrm(ks[14], (DEPTH, N_EXPERT_GROUPS), 0.01)
    w_expert_router = nrm(ks[15], (DEPTH, N_EXPERT_GROUPS, D_MODEL, EXPERTS_PER_GROUP), D_MODEL ** -0.5)
    b_expert_router = nrm(ks[16], (DEPTH, N_EXPERT_GROUPS, EXPERTS_PER_GROUP), 0.01)
    w_gate = nrm(ks[17], (DEPTH, N_EXPERTS, D_MODEL, D_EXPERT), D_MODEL ** -0.5)
    w_up = nrm(ks[18], (DEPTH, N_EXPERTS, D_MODEL, D_EXPERT), D_MODEL ** -0.5)
    w_down = nrm(ks[19], (DEPTH, N_EXPERTS, D_EXPERT, D_MODEL), D_EXPERT ** -0.5)
    return {"x": x, "positions": positions, "norm1_w": norm1_w, "w_in": w_in,
            "conv_w": conv_w, "conv_b": conv_b, "dt_bias": dt_bias, "A_log": A_log,
            "D_skip": D_skip, "ssd_norm_w": ssd_norm_w, "q_norm_w": q_norm_w,
            "k_norm_w": k_norm_w, "w_out": w_out, "norm2_w": norm2_w,
            "w_group_router": w_group_router, "b_group_router": b_group_router,
            "w_expert_router": w_expert_router, "b_expert_router": b_expert_router,
            "w_gate": w_gate, "w_up": w_up, "w_down": w_down}


def reference(x, positions, norm1_w, w_in, conv_w, conv_b, dt_bias, A_log, D_skip, ssd_norm_w,
              q_norm_w, k_norm_w, w_out, norm2_w, w_group_router, b_group_router,
              w_expert_router, b_expert_router, w_gate, w_up, w_down):
    b, s, _ = x.shape
    h = x
    for i in range(DEPTH):
        hn = rmsnorm(h, norm1_w[i])
        proj = jnp.dot(hn, w_in[i])
        z, xs, Bm, Cm, dt_raw, q, k, v = jnp.split(proj, PROJ_SPLITS, axis=-1)

        xbc = jax.nn.silu(causal_depthwise_conv(jnp.concatenate([xs, Bm, Cm], axis=-1), conv_w[i], conv_b[i]))
        xs, Bm, Cm = jnp.split(xbc, (SSD_D_INNER, SSD_D_INNER + SSD_GROUPS * SSD_D_STATE), axis=-1)
        dt = jax.nn.softplus(dt_raw.astype(jnp.float32) + dt_bias[i].astype(jnp.float32))
        A = -jnp.exp(A_log[i].astype(jnp.float32))
        xh = xs.reshape(b, s, SSD_HEADS, SSD_HEAD_DIM).astype(jnp.float32)
        y = ssd_chunked(xh, dt, A,
                        Bm.reshape(b, s, SSD_GROUPS, SSD_D_STATE).astype(jnp.float32),
                        Cm.reshape(b, s, SSD_GROUPS, SSD_D_STATE).astype(jnp.float32))
        y = y + D_skip[i].astype(jnp.float32)[:, None] * xh
        yg = (y.reshape(b, s, SSD_D_INNER) * jax.nn.silu(z.astype(jnp.float32)))
        yg = yg.reshape(b, s, SSD_GROUPS, SSD_D_INNER // SSD_GROUPS)
        yg = yg * lax.rsqrt(jnp.mean(yg * yg, axis=-1, keepdims=True) + EPS)
        y_ssd = (yg.reshape(b, s, SSD_D_INNER) * ssd_norm_w[i].astype(jnp.float32)).astype(h.dtype)

        q = rmsnorm(q.reshape(b, s, ATTN_HEADS, ATTN_HEAD_DIM), q_norm_w[i])
        k = rmsnorm(k.reshape(b, s, ATTN_HEADS, ATTN_HEAD_DIM), k_norm_w[i])
        v = v.reshape(b, s, ATTN_HEADS, ATTN_HEAD_DIM)
        q = partial_rotary(q, positions)
        k = partial_rotary(k, positions)
        y_attn = dilated_mixture_attention(q, k, v).reshape(b, s, ATTN_D).astype(h.dtype)

        mix = jnp.concatenate([y_ssd, y_attn], axis=-1)
        h = h + jnp.dot(mix, w_out[i])

        hn2 = rmsnorm(h, norm2_w[i]).reshape(b * s, D_MODEL)
        moe = hierarchical_moe(hn2, i, w_group_router, b_group_router, w_expert_router,
                               b_expert_router, w_gate, w_up, w_down)
        h = h + moe.reshape(b, s, D_MODEL).astype(h.dtype)
    return h
```

```cpp
#include <hip/hip_runtime.h>
#include <cstdio>
#include <cstdint>
#include <cmath>
namespace pg8 {
#define PG8_LAS __attribute__((address_space(3)))
typedef unsigned short bf16_t;
typedef short bf16x8 __attribute__((ext_vector_type(8)));
typedef float f32x4 __attribute__((ext_vector_type(4)));
typedef unsigned u32x4 __attribute__((ext_vector_type(4)));
constexpr int BM = 256, BK = 64, HALF = 128, HTB = HALF * BK * 2  , STAGE_BYTES = 8 * HTB, NXCD = 8, WGM = 8;

__host__ __device__ __forceinline__ int lds_byte(int r, int c) { const int st = (r >> 4) * 2 + (c >> 5), rr = r & 15, cc = c & 31, ob = rr * 64 + cc * 2; return st * 1024 + (ob ^ (((ob >> 9) & 1) << 5)); }
__host__ __device__ __forceinline__ void stage_rc(int b, int& R, int& C) { const int st = b / 1024, sb = b % 1024, swz = sb ^ (((sb >> 9) & 1) << 5); R = (st >> 1) * 16 + swz / 64; C = (st & 1) * 32 + (swz % 64) / 2; }
__host__ __device__ __forceinline__ int perm32(int rho) { const int n = rho >> 4, i = rho & 15; return 8 * (i >> 2) + 4 * n + (i & 3); }

struct Unit { int pm, pn; };
struct Gemm { const bf16_t* A; const bf16_t* Bt; int M, N, K; };

struct StaticOrder {
    int nM, nN, nwg, G, c;
    __host__ __device__ void init(int M, int N, int G_, int c_) { nM = M / BM; nN = N / BM; nwg = nM * nN; G = G_; c = c_; }
    __host__ __device__ bool next(int i, Unit& u) const {
        const long L = (long)i * G + c; if (L >= nwg) return false;
        int wgid = (int)L; { const int q = nwg / NXCD, r = nwg % NXCD, xcd = wgid % NXCD, off = wgid / NXCD; wgid = (xcd < r ? xcd * (q + 1) : r * (q + 1) + (xcd - r) * q) + off; }
        const int nig = WGM * nN, gid = wgid / nig, fm = gid * WGM, gsz = (nM - fm) < WGM ? (nM - fm) : WGM;
        u.pm = fm + ((wgid % nig) % gsz); u.pn = (wgid % nig) / gsz; return true;
    }
    __device__ __forceinline__ size_t boff(const Unit&) const { return 0; }
    __device__ __forceinline__ void a_ready(const Unit&) const {}
    __device__ __forceinline__ void done(const Unit&) const {}
};

__device__ __forceinline__ unsigned cvt_pk_bf16(float lo, float hi) { unsigned r; asm volatile("v_cvt_pk_bf16_f32 %0, %1, %2" : "=v"(r) : "v"(lo), "v"(hi)); return r; }
typedef float f32x2 __attribute__((ext_vector_type(2)));
__device__ __forceinline__ f32x2 gelu_pk(f32x2 v) {
    const f32x2 av = __builtin_elementwise_abs(v), d = av * 0.2316418882f + 1.0f;
    f32x2 t; t.x = __builtin_amdgcn_rcpf(d.x); t.y = __builtin_amdgcn_rcpf(d.y);
    f32x2 q = t * 0.5307027145f + (-0.7265760135f); q = q * t + 0.7107068705f; q = q * t + (-0.142248368f); q = q * t + 0.127414796f; q = q * t;
    const f32x2 s = (v * v) * (-0.72134752044f);
    f32x2 e; e.x = __builtin_amdgcn_exp2f(s.x); e.y = __builtin_amdgcn_exp2f(s.y);
    const f32x2 m = v * (q * e), r = v - m;
    f32x2 o; o.x = v.x < 0.f ? m.x : r.x; o.y = v.y < 0.f ? m.y : r.y; return o;
}

template <int ACT  > struct EpiBf16 {
    static constexpr bool PERM = true, AFTER_DRAIN = false; static_assert(ACT == 0 || ACT == 1, "EpiBf16: ACT is 0 (none) or 1 (gelu_pk)");
    bf16_t* O; int ldc; const float* bias; int split_cols; size_t split_stride; float scale0;
    __device__ __forceinline__ void operator()(const f32x4 (&acc)[2][2][4][2], const Unit& u, int wr, int wc, int fr, int fq) const {
        const int row0 = u.pm * BM + wr * 64 + fr; int colt = u.pn * BM; bf16_t* base = O;
        float sc = 1.f; if (split_cols) { const int t = colt / split_cols; base += (size_t)t * split_stride; colt -= t * split_cols; if (t == 0) sc = scale0; }
        const int col0 = colt + wc * 32 + 8 * fq, bcol0 = u.pn * BM + wc * 32 + 8 * fq;
        f32x4 bv[2][2];
#pragma unroll
        for (int bj = 0; bj < 2; ++bj)
#pragma unroll
            for (int n = 0; n < 2; ++n) bv[bj][n] = bias ? *(const f32x4*)(bias + bcol0 + bj * HALF + 4 * n) : (f32x4){0.f, 0.f, 0.f, 0.f};
#pragma unroll
        for (int ai = 0; ai < 2; ++ai)
#pragma unroll
            for (int m = 0; m < 4; ++m) { bf16_t* rowp = base + (size_t)(row0 + ai * HALF + m * 16) * ldc + col0;
#pragma unroll
                for (int bj = 0; bj < 2; ++bj) { f32x4 v0 = acc[ai][bj][m][0] + bv[bj][0], v1 = acc[ai][bj][m][1] + bv[bj][1];
                    if (ACT == 1) { f32x2 a = gelu_pk((f32x2){v0[0], v0[1]}), b = gelu_pk((f32x2){v0[2], v0[3]}), c = gelu_pk((f32x2){v1[0], v1[1]}), d = gelu_pk((f32x2){v1[2], v1[3]});
                        v0 = (f32x4){a.x, a.y, b.x, b.y}; v1 = (f32x4){c.x, c.y, d.x, d.y}; }
                    v0 = v0 * sc; v1 = v1 * sc; u32x4 w; w.x = cvt_pk_bf16(v0[0], v0[1]); w.y = cvt_pk_bf16(v0[2], v0[3]); w.z = cvt_pk_bf16(v1[0], v1[1]); w.w = cvt_pk_bf16(v1[2], v1[3]);
                    *(u32x4*)(rowp + bj * HALF) = w; } }
    }
};
__device__ __forceinline__ float silu_f(float g) { return g * __builtin_amdgcn_rcpf(1.0f + __expf(-g)); }
struct EpiResF32 {
    static constexpr bool PERM = false, AFTER_DRAIN = false;
    const float* base; float* out; int ldc;
    __device__ __forceinline__ void operator()(const f32x4 (&acc)[2][2][4][2], const Unit& u, int wr, int wc, int fr, int fq) const {
        const int row0 = u.pm * BM + wr * 64 + fr, col0 = u.pn * BM + wc * 32 + 4 * fq;
#pragma unroll
        for (int ai = 0; ai < 2; ++ai)
#pragma unroll
            for (int m = 0; m < 4; ++m) { const size_t off = (size_t)(row0 + ai * HALF + m * 16) * ldc + col0;
#pragma unroll
                for (int bj = 0; bj < 2; ++bj)
#pragma unroll
                    for (int n = 0; n < 2; ++n) { const f32x4 b = *(const f32x4*)(base + off + bj * HALF + n * 16); *(f32x4*)(out + off + bj * HALF + n * 16) = b + acc[ai][bj][m][n]; }
                asm volatile("" ::: "memory"); }
    }
};
struct EpiSwiglu {
    static constexpr bool PERM = true, AFTER_DRAIN = false;
    bf16_t* O; int ldc;
    __device__ __forceinline__ void operator()(const f32x4 (&acc)[2][2][4][2], const Unit& u, int wr, int wc, int fr, int fq) const {
        const int row0 = u.pm * BM + wr * 64 + fr, col0 = u.pn * HALF + wc * 32 + 8 * fq;
#pragma unroll
        for (int ai = 0; ai < 2; ++ai)
#pragma unroll
            for (int m = 0; m < 4; ++m) { bf16_t* rowp = O + (size_t)(row0 + ai * HALF + m * 16) * ldc + col0;
                const f32x4 g0 = acc[ai][0][m][0], g1 = acc[ai][0][m][1], u0 = acc[ai][1][m][0], u1 = acc[ai][1][m][1];
                u32x4 w; w.x = cvt_pk_bf16(silu_f(g0[0]) * u0[0], silu_f(g0[1]) * u0[1]); w.y = cvt_pk_bf16(silu_f(g0[2]) * u0[2], silu_f(g0[3]) * u0[3]);
                w.z = cvt_pk_bf16(silu_f(g1[0]) * u1[0], silu_f(g1[1]) * u1[1]); w.w = cvt_pk_bf16(silu_f(g1[2]) * u1[2], silu_f(g1[3]) * u1[3]);
                *(u32x4*)rowp = w; }
    }
};
struct MoeOrder {
    const PG8_LAS int* tile_e; int ntiles, nN, G, c; size_t estride;
    __device__ __forceinline__ bool next(int i, Unit& u) const { const long L = (long)i * G + c; if (L >= (long)ntiles * nN) return false; u.pm = (int)(L / nN); u.pn = (int)(L % nN); return true; }
    __device__ __forceinline__ size_t boff(const Unit& u) const { return (size_t)__builtin_amdgcn_readfirstlane(tile_e[u.pm]) * estride; }
    __device__ __forceinline__ void a_ready(const Unit&) const {}
    __device__ __forceinline__ void done(const Unit&) const {}
};
template <class Epi, class Sched, bool ALIGN_EPI = false, bool SP2 = false>
__device__ __forceinline__ void gemm_phase(PG8_LAS unsigned char* lds, const Gemm g, const Sched& S, const Epi& E) {
    const int tid = threadIdx.x, wid = __builtin_amdgcn_readfirstlane(tid >> 6), lane = tid & 63, wr = wid >> 2, wc = wid & 3, fr = lane & 15, fq = lane >> 4;
    const int K = g.K, nt = K / BK;
    unsigned voffA[2], voffB[2];
#pragma unroll
    for (int i = 0; i < 2; ++i) { int R, C; stage_rc(tid * 16 + i * 8192, R, C); const int Rb = Epi::PERM ? ((R & ~31) + perm32(R & 31)) : R;
        voffA[i] = (unsigned)(R * K + C) * 2u; voffB[i] = (unsigned)(Rb * K + C) * 2u; }
    const size_t kstep = (size_t)(BK * 2);
    const size_t hstep = (size_t)HALF * K * 2;
    const size_t tstep = 2 * hstep;
    const unsigned ldsw = (unsigned)wid * 1024u;
    const int aoff = lds_byte(wr * 64 + fr, fq * 8), boff = lds_byte(wc * 32 + fr, fq * 8);
#define PG8_SA(b, h) (((b) * 2 + (h)) * HTB)
#define PG8_SB(b, h) ((4 + (b) * 2 + (h)) * HTB)
#define PG8_STAGE(bufoff, gbase, voff) do { _Pragma("unroll") for (int _i = 0; _i < 2; ++_i) \
        __builtin_amdgcn_global_load_lds((const unsigned*)((const char*)(gbase) + (voff)[_i]), (PG8_LAS unsigned*)(lds + (bufoff) + ldsw + _i * 8192), 16, 0, 0); } while (0)
#define PG8_LDA(dst, b, h) do { _Pragma("unroll") for (int m = 0; m < 4; ++m) _Pragma("unroll") for (int k = 0; k < 2; ++k) dst[m][k] = *(const PG8_LAS bf16x8*)(lds + PG8_SA(b, h) + aoff + m * 2048 + k * 1024); } while (0)
#define PG8_LDB(dst, b, h) do { _Pragma("unroll") for (int n = 0; n < 2; ++n) _Pragma("unroll") for (int k = 0; k < 2; ++k) dst[n][k] = *(const PG8_LAS bf16x8*)(lds + PG8_SB(b, h) + boff + n * 2048 + k * 1024); } while (0)
#define PG8_MMA(ai, bj, At, Bt) do { __builtin_amdgcn_s_setprio(1); _Pragma("unroll") for (int m = 0; m < 4; ++m) _Pragma("unroll") for (int n = 0; n < 2; ++n) _Pragma("unroll") for (int k = 0; k < 2; ++k) \
        acc[ai][bj][m][n] = __builtin_amdgcn_mfma_f32_16x16x32_bf16(Bt[n][k], At[m][k], acc[ai][bj][m][n], 0, 0, 0); __builtin_amdgcn_s_setprio(0); } while (0)
#define PG8_WAIT_V(n) asm volatile("s_waitcnt vmcnt(" #n ")" ::: "memory")
#define PG8_WAIT_L(n) asm volatile("s_waitcnt lgkmcnt(" #n ")" ::: "memory")
#define PG8_BAR __builtin_amdgcn_s_barrier()
#define PG8_SCHED __builtin_amdgcn_sched_barrier(0)
    Unit cur, nxt; int ui = 0;
    if (!S.next(0, cur)) return;
    f32x4 acc[2][2][4][2];
#pragma unroll
    for (int a = 0; a < 2; ++a)
#pragma unroll
        for (int b = 0; b < 2; ++b)
#pragma unroll
            for (int m = 0; m < 4; ++m)
#pragma unroll
                for (int n = 0; n < 2; ++n) acc[a][b][m][n] = (f32x4){0.f, 0.f, 0.f, 0.f};
    bf16x8 At[4][2], B0[2][2], B1[2][2];
    const char* cA = (const char*)g.A + (size_t)cur.pm * tstep; const char* cB = (const char*)g.Bt + S.boff(cur) + (size_t)cur.pn * tstep;
    S.a_ready(cur);
    if constexpr (SP2) {
        PG8_STAGE(PG8_SB(0, 0), cB, voffB); PG8_STAGE(PG8_SB(0, 1), cB + hstep, voffB); PG8_STAGE(PG8_SA(0, 0), cA, voffA); PG8_STAGE(PG8_SA(0, 1), cA + hstep, voffA);
        if (wr == 1) PG8_BAR;
        PG8_WAIT_V(2); PG8_BAR;
        PG8_STAGE(PG8_SB(1, 0), cB + kstep, voffB); PG8_STAGE(PG8_SA(1, 0), cA + kstep, voffA); PG8_STAGE(PG8_SB(1, 1), cB + hstep + kstep, voffB);
        PG8_WAIT_V(6); PG8_BAR;
    } else {
        PG8_STAGE(PG8_SB(0, 0), cB, voffB); PG8_STAGE(PG8_SA(0, 0), cA, voffA); PG8_STAGE(PG8_SB(0, 1), cB + hstep, voffB); PG8_STAGE(PG8_SA(0, 1), cA + hstep, voffA);
        if (wr == 1) PG8_BAR;
        PG8_WAIT_V(4); PG8_BAR;
        PG8_STAGE(PG8_SB(1, 0), cB + kstep, voffB); PG8_STAGE(PG8_SA(1, 0), cA + kstep, voffA); PG8_STAGE(PG8_SB(1, 1), cB + hstep + kstep, voffB);
        PG8_WAIT_V(6); PG8_BAR;
    }
    for (;;) {
        const bool has_next = S.next(ui + 1, nxt);
        const char* nA = has_next ? (const char*)g.A + (size_t)nxt.pm * tstep : cA; const char* nB = has_next ? (const char*)g.Bt + S.boff(nxt) + (size_t)nxt.pn * tstep : cB;
        for (int t = 0; t < nt; t += 2) {
            const bool last = (t == nt - 2);
            const char* a1 = cA + (size_t)(t + 1) * kstep;
            const char* a2 = last ? nA : cA + (size_t)(t + 2) * kstep; const char* b2 = last ? nB : cB + (size_t)(t + 2) * kstep;
            const char* a3 = a2 + kstep; const char* b3 = b2 + kstep;
            if (last && has_next) S.a_ready(nxt);
            if constexpr (SP2) {
            PG8_LDB(B0, 0, 0); PG8_LDB(B1, 0, 1); PG8_SCHED; PG8_LDA(At, 0, 0); PG8_STAGE(PG8_SA(1, 1), a1 + hstep, voffA);
            PG8_WAIT_V(8); PG8_WAIT_L(0); PG8_BAR; PG8_MMA(0, 0, At, B0); PG8_MMA(0, 1, At, B1); PG8_BAR; PG8_SCHED;
            PG8_LDA(At, 0, 1); PG8_STAGE(PG8_SB(0, 0), b2, voffB); PG8_STAGE(PG8_SB(0, 1), b2 + hstep, voffB); PG8_STAGE(PG8_SA(0, 0), a2, voffA);
            PG8_WAIT_V(8); PG8_WAIT_L(0); PG8_BAR; PG8_MMA(1, 0, At, B0); PG8_MMA(1, 1, At, B1); PG8_BAR; PG8_SCHED;
            PG8_LDB(B0, 1, 0); PG8_LDB(B1, 1, 1); PG8_SCHED; PG8_LDA(At, 1, 0); PG8_STAGE(PG8_SA(0, 1), a2 + hstep, voffA);
            PG8_WAIT_V(8); PG8_WAIT_L(0); PG8_BAR; PG8_MMA(0, 0, At, B0); PG8_MMA(0, 1, At, B1); PG8_BAR; PG8_SCHED;
            PG8_LDA(At, 1, 1); PG8_STAGE(PG8_SB(1, 0), b3, voffB); PG8_STAGE(PG8_SB(1, 1), b3 + hstep, voffB); PG8_STAGE(PG8_SA(1, 0), a3, voffA);
            PG8_WAIT_V(8); PG8_WAIT_L(0); PG8_BAR; PG8_MMA(1, 0, At, B0); PG8_MMA(1, 1, At, B1); PG8_BAR; PG8_SCHED;
            } else {
            PG8_LDB(B0, 0, 0); PG8_SCHED; PG8_LDA(At, 0, 0); PG8_STAGE(PG8_SA(1, 1), a1 + hstep, voffA);
            PG8_WAIT_L(8); PG8_BAR; PG8_WAIT_L(0); PG8_MMA(0, 0, At, B0); PG8_BAR; PG8_SCHED;
            PG8_LDB(B1, 0, 1); PG8_STAGE(PG8_SB(0, 0), b2, voffB);
            PG8_BAR; PG8_WAIT_L(0); PG8_MMA(0, 1, At, B1); PG8_BAR;
            PG8_LDA(At, 0, 1); PG8_STAGE(PG8_SA(0, 0), a2, voffA);
            PG8_BAR; PG8_WAIT_L(0); PG8_MMA(1, 0, At, B0); PG8_BAR; PG8_SCHED;
            PG8_STAGE(PG8_SB(0, 1), b2 + hstep, voffB);
            PG8_WAIT_V(6); PG8_BAR; PG8_MMA(1, 1, At, B1); PG8_BAR;
            PG8_LDB(B0, 1, 0); PG8_SCHED; PG8_LDA(At, 1, 0); PG8_STAGE(PG8_SA(0, 1), a2 + hstep, voffA);
            PG8_WAIT_L(8); PG8_BAR; PG8_WAIT_L(0); PG8_MMA(0, 0, At, B0); PG8_BAR; PG8_SCHED;
            PG8_LDB(B1, 1, 1); PG8_STAGE(PG8_SB(1, 0), b3, voffB);
            PG8_BAR; PG8_WAIT_L(0); PG8_MMA(0, 1, At, B1); PG8_BAR;
            PG8_LDA(At, 1, 1); PG8_STAGE(PG8_SA(1, 0), a3, voffA);
            PG8_BAR; PG8_WAIT_L(0); PG8_MMA(1, 0, At, B0); PG8_BAR; PG8_SCHED;
            PG8_STAGE(PG8_SB(1, 1), b3 + hstep, voffB);
            PG8_WAIT_V(6); PG8_BAR; PG8_MMA(1, 1, At, B1); PG8_BAR;
            }
        }
        if constexpr (ALIGN_EPI) { if (wr == 0) PG8_BAR; }
        if constexpr (!Epi::AFTER_DRAIN) { E(acc, cur, wr, wc, fr, fq); S.done(cur); }
        if (!has_next) break;
#pragma unroll
        for (int a = 0; a < 2; ++a)
#pragma unroll
            for (int b = 0; b < 2; ++b)
#pragma unroll
                for (int m = 0; m < 4; ++m)
#pragma unroll
                    for (int n = 0; n < 2; ++n) acc[a][b][m][n] = (f32x4){0.f, 0.f, 0.f, 0.f};
        cur = nxt; cA = nA; cB = nB; ++ui;
        if constexpr (ALIGN_EPI) { if (wr == 1) PG8_BAR; }
    }
    PG8_WAIT_V(0);
    if constexpr (!ALIGN_EPI) { if (wr == 0) PG8_BAR; }
    PG8_BAR;
    if constexpr (Epi::AFTER_DRAIN) { E.fused(acc, cur, wr, wc, fr, fq, lds, wid, lane); S.done(cur); }
#undef PG8_SA
#undef PG8_SB
#undef PG8_STAGE
#undef PG8_LDA
#undef PG8_LDB
#undef PG8_MMA
#undef PG8_WAIT_V
#undef PG8_WAIT_L
#undef PG8_BAR
#undef PG8_SCHED
}
}
#define GAS __attribute__((address_space(1)))
#define LAS __attribute__((address_space(3)))
typedef unsigned short bf16;
typedef unsigned v4u __attribute__((ext_vector_type(4)));
typedef float f32x4 __attribute__((ext_vector_type(4)));
typedef short bf16x8 __attribute__((ext_vector_type(8)));
typedef GAS unsigned gu32;
typedef GAS unsigned long long gu64;
#define RLX_AGENT __ATOMIC_RELAXED, __HIP_MEMORY_SCOPE_AGENT
#define LDS_WAIT() asm volatile("s_waitcnt lgkmcnt(0)" ::: "memory")
#define VM_WAIT() asm volatile("s_waitcnt vmcnt(0)" ::: "memory")
__device__ __forceinline__ unsigned long long rt() { return __builtin_amdgcn_s_memrealtime(); }
__device__ __forceinline__ unsigned f2bf(float f) { unsigned u = __builtin_bit_cast(unsigned, f); return (u + 0x7fffu + ((u >> 16) & 1u)) >> 16; }
__device__ __forceinline__ unsigned pk2(float lo, float hi) { return f2bf(lo) | (f2bf(hi) << 16); }

#define XB_TMO      128
#define XB_XCNT(j)  (256  + 64 * (j))
#define XB_XSUB(j)  (1280 + 64 * (j))
#define XB_XGEN(j)  (2304 + 64 * (j))
#define XB_TOP      3328
#define XB_TOPGEN   3392
#define XCD_BAR_WORDS 3456
#define XB_SPIN_CAP (1u << 18)

__device__ __forceinline__ unsigned xb_ld(unsigned* p)              { return __hip_atomic_load(p, __ATOMIC_RELAXED, __HIP_MEMORY_SCOPE_AGENT); }
__device__ __forceinline__ unsigned xb_add(unsigned* p, unsigned v) { return __hip_atomic_fetch_add(p, v, __ATOMIC_RELAXED, __HIP_MEMORY_SCOPE_AGENT); }
__device__ __forceinline__ unsigned xb_xcc_id() { return (unsigned)__builtin_amdgcn_s_getreg((3 << 11) | 20) & 0xFu; }
#define XB_SPIN(cond, bar) do { unsigned _sp = 0; while (cond) { __builtin_amdgcn_s_sleep(1); \
    if ((++_sp & 255u) == 0u) { if (xb_ld(&(bar)[XB_TMO])) break; if (_sp > XB_SPIN_CAP) { atomicAdd(&(bar)[XB_TMO], 1u); break; } } } } while (0)

struct XcdBarrier {
    unsigned* bar; unsigned x;
    volatile LAS unsigned* st;
};

__device__ __forceinline__ XcdBarrier xcd_barrier_post(unsigned* bar, volatile LAS unsigned* st) {
    XcdBarrier b; b.bar = bar; b.x = xb_xcc_id(); b.st = st;
    if (threadIdx.x == 0) (void)xb_add(&bar[XB_XCNT(b.x)], 1u);
    return b;
}
__device__ __forceinline__ void xcd_barrier_complete(unsigned* bar, unsigned x, unsigned& nloc, unsigned& nx) {
    const unsigned G = gridDim.x * gridDim.y * gridDim.z;
    unsigned sum, cnt, mine, sp = 0u;
    for (;;) {
        sum = 0u; cnt = 0u; mine = 0u;
#pragma unroll
        for (unsigned j = 0; j < 16; ++j) { const unsigned c = xb_ld(&bar[XB_XCNT(j)]); sum += c; cnt += (c > 0u) ? 1u : 0u; mine = (j == x) ? c : mine; }
        if (sum == G) break;
        __builtin_amdgcn_s_sleep(1);
        if ((++sp & 255u) == 0u) { if (xb_ld(&bar[XB_TMO])) break; if (sp > XB_SPIN_CAP) { atomicAdd(&bar[XB_TMO], 1u); break; } }
    }
    nloc = mine > 0u ? mine : 1u; nx = cnt > 0u ? cnt : 1u;
}

__device__ __forceinline__ void xcd_barrier(const XcdBarrier& b) {
    asm volatile("s_waitcnt vmcnt(0)" ::: "memory");
    __syncthreads();
    if (threadIdx.x == 0) {
        unsigned* bar = b.bar;
        __builtin_amdgcn_s_waitcnt(0);
        unsigned nloc = b.st[0], nx = b.st[1];
        if (nloc == 0u) { xcd_barrier_complete(bar, b.x, nloc, nx); b.st[0] = nloc; b.st[1] = nx; }
        const unsigned old = xb_add(&bar[XB_XSUB(b.x)], 1u);
        const unsigned gen = old / nloc;
        if (old + 1u == (gen + 1u) * nloc) {
            __builtin_amdgcn_fence(__ATOMIC_RELEASE, "agent");
            asm volatile("s_waitcnt vmcnt(0)" ::: "memory");
            const unsigned og = xb_add(&bar[XB_TOP], 1u);
            const unsigned tg = og / nx;
            if (og + 1u == (tg + 1u) * nx) xb_add(&bar[XB_TOPGEN], 1u);
            else XB_SPIN(xb_ld(&bar[XB_TOPGEN]) == tg, bar);
            __builtin_amdgcn_fence(__ATOMIC_ACQUIRE, "agent");
            xb_add(&bar[XB_XGEN(b.x)], 1u);
            asm volatile("s_waitcnt vmcnt(0)" ::: "memory");
        } else {
            XB_SPIN(xb_ld(&bar[XB_XGEN(b.x)]) == gen, bar);
            __builtin_amdgcn_fence(__ATOMIC_ACQUIRE, "agent");
            asm volatile("s_waitcnt vmcnt(0)" ::: "memory");
        }
    }
    __syncthreads();
}

constexpr int NWAVES = 8;
constexpr int T = 16384, D = 2048, NPROJ = 8192, NPROJ_SRC = 8224, DMIX = 3072, NCONV = 3072;
constexpr int NEXP = 64, DEXP = 1024;
constexpr float EPS = 1e-6f;
constexpr size_t MiB = 1u << 20;
constexpr size_t WS_CTL = 0, CTL_ZERO_BYTES = 1 * MiB;
constexpr size_t WS_DT = 2 * MiB;
constexpr size_t WS_EID = 4 * MiB;
constexpr size_t WS_GATE = WS_EID + 256 * 1024;
constexpr size_t WS_POS = WS_GATE + 256 * 1024;
constexpr size_t WS_DEST = WS_POS + 256 * 1024;
constexpr size_t WS_TILE = WS_DEST + 256 * 1024;
constexpr size_t WS_W1T = 8 * MiB;
constexpr size_t WS_WOT = 42 * MiB;
constexpr size_t WS_WGU = 54 * MiB;
constexpr size_t WS_WD = 566 * MiB;
constexpr size_t WS_HN = 822 * MiB;
constexpr size_t WS_PROJ = 886 * MiB;
constexpr size_t WS_XBC = 1142 * MiB;
constexpr size_t WS_YS = 1238 * MiB;
constexpr size_t WS_MIX = 1366 * MiB;
constexpr size_t WS_END = 1462 * MiB;
constexpr size_t WS_XG = 886 * MiB;
constexpr size_t WS_HID = 1078 * MiB;
constexpr size_t WS_Y = 1174 * MiB;
constexpr int CW_TMO = 0, CW_CODE = 1, CW_CNT = 64, CW_BAR = 4096;
constexpr int RING_OFF = 0, RING_BYTES = 131072;
constexpr int LDSCTL_OFF = RING_BYTES, MISC_OFF = LDSCTL_OFF + 320;
constexpr int TAB_OFF = RING_BYTES + 1024;
constexpr int LDS_BYTES = 147456;

struct Args { const void* in[21]; float* out; unsigned char* ws; int ph_lo, ph_hi; };
struct Frame { LAS unsigned char* lds; volatile LAS unsigned* MISC; gu32* ctl; int tid, lane, wave, vcu, G, gw, NGW; };

__device__ __forceinline__ float bflo(unsigned w) { return __uint_as_float(w << 16); }
__device__ __forceinline__ float bfhi(unsigned w) { return __uint_as_float(w & 0xffff0000u); }
__device__ __forceinline__ float bf2f(unsigned short b) { return __uint_as_float((unsigned)b << 16); }
__device__ __forceinline__ float wave_sum(float v) {
#pragma unroll
    for (int o = 1; o < 64; o <<= 1) v += __shfl_xor(v, o);
    return v;
}
__device__ __forceinline__ float wave_max(float v) {
#pragma unroll
    for (int o = 1; o < 64; o <<= 1) v = fmaxf(v, __shfl_xor(v, o));
    return v;
}
template <int CTRL> __device__ __forceinline__ float dppf(float x) { return __builtin_bit_cast(float, __builtin_amdgcn_mov_dpp(__builtin_bit_cast(int, x), CTRL, 0xf, 0xf, true)); }
__device__ __forceinline__ float row16_sum(float v) {
    v += dppf<0xB1>(v); v += dppf<0x4E>(v); v += dppf<0x141>(v); v += dppf<0x140>(v); return v;
}
__device__ __forceinline__ float silu(float g) { return g / (1.0f + __expf(-g)); }

__device__ __forceinline__ void tr_item(const float* W, int N, int k0, int n0, bf16* WT, int Kd, int drow0, LAS float* scr, int lane) {
#pragma unroll 8
    for (int i = 0; i < 32; ++i) { const int kk = 2 * i + (lane >> 5); scr[kk * 33 + (lane & 31)] = W[(size_t)(k0 + kk) * N + n0 + (lane & 31)]; }
    LDS_WAIT(); asm volatile("" ::: "memory");
    const int c = lane & 7;
#pragma unroll
    for (int j = 0; j < 4; ++j) { const int n = (lane >> 3) + 8 * j; const LAS float* s = scr + (8 * c) * 33 + n;
        v4u o; o.x = pk2(s[0 * 33], s[1 * 33]); o.y = pk2(s[2 * 33], s[3 * 33]); o.z = pk2(s[4 * 33], s[5 * 33]); o.w = pk2(s[6 * 33], s[7 * 33]);
        *(GAS v4u*)(WT + (size_t)(drow0 + n) * Kd + k0 + 8 * c) = o; }
    LDS_WAIT(); asm volatile("" ::: "memory");
}
__device__ __forceinline__ void rms_row_to_bf16(const float* xrow, const float* w, bf16* orow, int lane) {
    const GAS f32x4* xr = (const GAS f32x4*)xrow + lane; const GAS f32x4* wr = (const GAS f32x4*)w + lane;
    f32x4 v[8]; float s = 0.f;
#pragma unroll
    for (int j = 0; j < 8; ++j) { v[j] = xr[64 * j]; s += (v[j].x * v[j].x + v[j].y * v[j].y) + (v[j].z * v[j].z + v[j].w * v[j].w); }
    const float rstd = 1.0f / sqrtf(wave_sum(s) * (1.0f / D) + EPS);
    GAS unsigned long long* o8 = (GAS unsigned long long*)orow + lane;
#pragma unroll
    for (int j = 0; j < 8; ++j) { const f32x4 ww = wr[64 * j]; const f32x4 o = v[j] * rstd * ww;
        o8[64 * j] = (unsigned long long)pk2(o.x, o.y) | ((unsigned long long)pk2(o.z, o.w) << 32); }
}
__device__ __forceinline__ void p0_prologue(const Args& a, Frame& F) {
    LAS float* scr = (LAS float*)(F.lds + RING_OFF + F.wave * 16384);
    const float* w_in = (const float*)a.in[3]; const float* w_out = (const float*)a.in[12];
    const float* w_gate = (const float*)a.in[18]; const float* w_up = (const float*)a.in[19]; const float* w_down = (const float*)a.in[20];
    bf16* W1T = (bf16*)(a.ws + WS_W1T); bf16* WOT = (bf16*)(a.ws + WS_WOT); bf16* WGU = (bf16*)(a.ws + WS_WGU); bf16* WDT = (bf16*)(a.ws + WS_WD);
    constexpr int NB_IN = NPROJ_SRC / 32;
    constexpr int I_IN = (D / 64) * NB_IN, I_OUT = (DMIX / 64) * (D / 32), I_G = (D / 64) * (DEXP / 32), I_D = (DEXP / 64) * (D / 32), I_E = 2 * I_G + I_D;
    constexpr int NITEMS = I_IN + I_OUT + NEXP * I_E;
    for (int it = F.gw; it < NITEMS; it += F.NGW) {
        int r = it;
        if (r < I_IN) { const int kb = r / NB_IN, nb = r % NB_IN, n0 = nb * 32;
            const int drow = n0 < 5120 ? n0 : (n0 < 5152 ? 8192 + (n0 - 5120) : n0 - 32);
            tr_item(w_in, NPROJ_SRC, kb * 64, n0, W1T, D, drow, scr, F.lane); continue; }
        r -= I_IN;
        if (r < I_OUT) { const int kb = r / (D / 32), nb = r % (D / 32); tr_item(w_out, D, kb * 64, nb * 32, WOT, DMIX, nb * 32, scr, F.lane); continue; }
        r -= I_OUT;
        const int e = r / I_E; int rr = r % I_E;
        if (rr < 2 * I_G) { const int up = rr >= I_G; rr -= up * I_G; const int kb = rr / (DEXP / 32), nb = rr % (DEXP / 32), n0 = nb * 32;
            const int drow = (n0 >> 7) * 256 + (n0 & 127) + up * 128;
            tr_item((up ? w_up : w_gate) + (size_t)e * D * DEXP, DEXP, kb * 64, n0, WGU + (size_t)e * 2048 * D, D, drow, scr, F.lane); continue; }
        rr -= 2 * I_G;
        { const int kb = rr / (D / 32), nb = rr % (D / 32); tr_item(w_down + (size_t)e * DEXP * D, D, kb * 64, nb * 32, WDT + (size_t)e * D * DEXP, DEXP, nb * 32, scr, F.lane); }
    }
    const float* x = (const float*)a.in[0]; const float* n1w = (const float*)a.in[2]; bf16* HN = (bf16*)(a.ws + WS_HN);
    for (int m = F.gw; m < T; m += F.NGW) rms_row_to_bf16(x + (size_t)m * D, n1w, HN + (size_t)m * D, F.lane);
}

__device__ __forceinline__ void p2_postproj(const Args& a, Frame& F) {
    bf16* PROJ = (bf16*)(a.ws + WS_PROJ); const bf16* HN = (const bf16*)(a.ws + WS_HN); const bf16* WDTT = (const bf16*)(a.ws + WS_W1T) + (size_t)8192 * D;
    float* DT = (float*)(a.ws + WS_DT); bf16* XBC = (bf16*)(a.ws + WS_XBC);
    const int lane = F.lane;
    { const float* dt_bias = (const float*)a.in[6];
      for (int it = F.gw; it < T / 16; it += F.NGW) {
        const int t0 = it * 16; f32x4 acc0 = {0.f, 0.f, 0.f, 0.f}, acc1 = {0.f, 0.f, 0.f, 0.f};
        const bf16* ap = HN + (size_t)(t0 + (lane & 15)) * D + 8 * (lane >> 4);
        const bf16* bp0 = WDTT + (size_t)(lane & 15) * D + 8 * (lane >> 4); const bf16* bp1 = bp0 + (size_t)16 * D;
#pragma unroll 4
        for (int s = 0; s < D / 32; ++s) { const bf16x8 av = *(const bf16x8*)(ap + 32 * s), b0 = *(const bf16x8*)(bp0 + 32 * s), b1 = *(const bf16x8*)(bp1 + 32 * s);
            acc0 = __builtin_amdgcn_mfma_f32_16x16x32_bf16(av, b0, acc0, 0, 0, 0); acc1 = __builtin_amdgcn_mfma_f32_16x16x32_bf16(av, b1, acc1, 0, 0, 0); }
        const int hd0 = lane & 15; const float bi0 = dt_bias[hd0], bi1 = dt_bias[16 + hd0];
#pragma unroll
        for (int r = 0; r < 4; ++r) { const int t = t0 + (lane >> 4) * 4 + r;
            float v0 = acc0[r] + bi0, v1 = acc1[r] + bi1;
            v0 = v0 > 20.f ? v0 : log1pf(expf(v0)); v1 = v1 > 20.f ? v1 : log1pf(expf(v1));
            DT[(size_t)t * 32 + hd0] = v0; DT[(size_t)t * 32 + 16 + hd0] = v1; }
      } }
    { const float* cw = (const float*)a.in[4]; const float* cb = (const float*)a.in[5];
      for (int it = F.gw; it < (T / 64) * (NCONV / 128); it += F.NGW) {
        const int tb = it / (NCONV / 128), cbk = it % (NCONV / 128), c = cbk * 128 + 2 * lane, t0 = tb * 64;
        const float w00 = cw[c], w01 = cw[c + 1], w10 = cw[NCONV + c], w11 = cw[NCONV + c + 1], w20 = cw[2 * NCONV + c], w21 = cw[2 * NCONV + c + 1], w30 = cw[3 * NCONV + c], w31 = cw[3 * NCONV + c + 1];
        const float b0 = cb[c], b1 = cb[c + 1];
        const bf16* src = PROJ + 2048 + c;
        float r00 = 0.f, r01 = 0.f, r10 = 0.f, r11 = 0.f, r20 = 0.f, r21 = 0.f;
        if (t0 > 0) { const unsigned u0 = *(const unsigned*)(src + (size_t)(t0 - 3) * NPROJ), u1 = *(const unsigned*)(src + (size_t)(t0 - 2) * NPROJ), u2 = *(const unsigned*)(src + (size_t)(t0 - 1) * NPROJ);
            r00 = bflo(u0); r01 = bfhi(u0); r10 = bflo(u1); r11 = bfhi(u1); r20 = bflo(u2); r21 = bfhi(u2); }
#pragma unroll 8
        for (int t = 0; t < 64; ++t) { const unsigned u = *(const unsigned*)(src + (size_t)(t0 + t) * NPROJ); const float c0 = bflo(u), c1 = bfhi(u);
            const float y0 = b0 + w00 * r00 + w10 * r10 + w20 * r20 + w30 * c0, y1 = b1 + w01 * r01 + w11 * r11 + w21 * r21 + w31 * c1;
            *(unsigned*)(XBC + (size_t)(t0 + t) * NCONV + c) = pk2(silu(y0), silu(y1));
            r00 = r10; r01 = r11; r10 = r20; r11 = r21; r20 = c0; r21 = c1; }
      } }
    { const int* positions = (const int*)a.in[1]; const float* qnw = (const float*)a.in[10]; const float* knw = (const float*)a.in[11];
      const int hv = lane >> 1, half = lane & 1; const float* nw = (hv < 16 ? qnw : knw) + half * 32;
      float nwv[32];
#pragma unroll
      for (int i = 0; i < 32; ++i) nwv[i] = nw[i];
      const float invf[8] = {1.0f, 0.19392274474868576f, 0.03760603093086393f, 0.007292664737217109f, 0.001414213562373095f, 0.0002742481756762073f, 5.318295896944988e-05f, 1.031338537721246e-05f};
      for (int t = F.gw; t < T; t += F.NGW) {
        v4u* p = (v4u*)(PROJ + (size_t)t * NPROJ + 5120 + lane * 32);
        float v[32]; float ss = 0.f;
#pragma unroll
        for (int j = 0; j < 4; ++j) { const v4u u = p[j];
            v[8 * j + 0] = bflo(u.x); v[8 * j + 1] = bfhi(u.x); v[8 * j + 2] = bflo(u.y); v[8 * j + 3] = bfhi(u.y); v[8 * j + 4] = bflo(u.z); v[8 * j + 5] = bfhi(u.z); v[8 * j + 6] = bflo(u.w); v[8 * j + 7] = bfhi(u.w); }
#pragma unroll
        for (int i = 0; i < 32; ++i) ss += v[i] * v[i];
        ss += dppf<0xB1>(ss);
        const float rstd = 1.0f / sqrtf(ss * (1.0f / 64.0f) + EPS);
#pragma unroll
        for (int i = 0; i < 32; ++i) v[i] = v[i] * rstd * nwv[i];
        if (half == 0) { const float pos = (float)positions[t];
#pragma unroll
            for (int i = 0; i < 8; ++i) { float sn, cs; sincosf(pos * invf[i], &sn, &cs); const float x1 = v[i], x2 = v[8 + i]; v[i] = x1 * cs - x2 * sn; v[8 + i] = x2 * cs + x1 * sn; } }
        const float sc = hv < 16 ? 0.125f : 1.0f;
#pragma unroll
        for (int j = 0; j < 4; ++j) { v4u u; u.x = pk2(v[8 * j + 0] * sc, v[8 * j + 1] * sc); u.y = pk2(v[8 * j + 2] * sc, v[8 * j + 3] * sc); u.z = pk2(v[8 * j + 4] * sc, v[8 * j + 5] * sc); u.w = pk2(v[8 * j + 6] * sc, v[8 * j + 7] * sc); p[j] = u; }
      } }
}

__device__ __forceinline__ void p3_ssd_seq(const Args& a, Frame& F) {
    const bf16* XBC = (const bf16*)(a.ws + WS_XBC); const float* DT = (const float*)(a.ws + WS_DT); float* YS = (float*)(a.ws + WS_YS);
    const float* A_log = (const float*)a.in[7];
    const int lane = F.lane, pq = lane >> 4, nq = lane & 15;
    for (int it = F.wave * F.G + (int)blockIdx.x; it < 32 * 16; it += F.NGW) {
        const int h = it >> 4, pg = it & 15, g = h >> 3, p = pg * 4 + pq;
        const float A = -expf(A_log[h]);
        float st[8];
#pragma unroll
        for (int j = 0; j < 8; ++j) st[j] = 0.f;
        const bf16* xb = XBC + h * 64 + p; const bf16* Bb = XBC + 2048 + g * 128 + 8 * nq; const bf16* Cb = XBC + 2560 + g * 128 + 8 * nq; const float* dtb = DT + h;
#pragma unroll 4
        for (int t = 0; t < T; ++t) {
            const float dt = dtb[(size_t)t * 32]; const float xv = bf2f(xb[(size_t)t * NCONV]);
            const v4u bu = *(const v4u*)(Bb + (size_t)t * NCONV), cu = *(const v4u*)(Cb + (size_t)t * NCONV);
            const float da = __expf(dt * A), dx = dt * xv;
            float y;
            st[0] = st[0] * da + dx * bflo(bu.x); y = bflo(cu.x) * st[0];
            st[1] = st[1] * da + dx * bfhi(bu.x); y += bfhi(cu.x) * st[1];
            st[2] = st[2] * da + dx * bflo(bu.y); y += bflo(cu.y) * st[2];
            st[3] = st[3] * da + dx * bfhi(bu.y); y += bfhi(cu.y) * st[3];
            st[4] = st[4] * da + dx * bflo(bu.z); y += bflo(cu.z) * st[4];
            st[5] = st[5] * da + dx * bfhi(bu.z); y += bfhi(cu.z) * st[5];
            st[6] = st[6] * da + dx * bflo(bu.w); y += bflo(cu.w) * st[6];
            st[7] = st[7] * da + dx * bfhi(bu.w); y += bfhi(cu.w) * st[7];
            y = row16_sum(y);
            if (nq == 0) YS[(size_t)t * D + h * 64 + p] = y;
        }
    }
}
__device__ __forceinline__ void p3_attn_naive(const Args& a, Frame& F) {
    const bf16* PROJ = (const bf16*)(a.ws + WS_PROJ); bf16* MIX = (bf16*)(a.ws + WS_MIX);
    LAS float* qs = (LAS float*)(F.lds + RING_OFF + F.wave * 16384);
    const int lane = F.lane;
    for (int it = F.gw; it < T * 16; it += F.NGW) {
        const int t = it >> 4, h = it & 15;
        qs[lane] = bf2f(PROJ[(size_t)t * NPROJ + 5120 + h * 64 + lane]);
        LDS_WAIT(); asm volatile("" ::: "memory");
        float qv[64];
#pragma unroll
        for (int i = 0; i < 16; ++i) { const f32x4 q4 = *(const LAS f32x4*)(qs + 4 * i); qv[4 * i] = q4.x; qv[4 * i + 1] = q4.y; qv[4 * i + 2] = q4.z; qv[4 * i + 3] = q4.w; }
        LDS_WAIT(); asm volatile("" ::: "memory");
        float M = -__builtin_inff(), L = 0.f, O = 0.f;
        const bf16* kb = PROJ + 6144 + h * 64; const bf16* vb = PROJ + 7168 + h * 64 + lane;
#pragma unroll
        for (int br = 0; br < 3; ++br) {
            const int d = br == 0 ? 1 : (br == 1 ? 4 : 16);
            float s[3]; bool ok[3];
#pragma unroll
            for (int jj = 0; jj < 3; ++jj) { const int j = lane + 64 * jj; const int kp = t - j * d; ok[jj] = (j <= 128) && (kp >= 0);
                const v4u* kr = (const v4u*)(kb + (size_t)(ok[jj] ? kp : 0) * NPROJ); float dot = 0.f;
#pragma unroll
                for (int c8 = 0; c8 < 8; ++c8) { const v4u u = kr[c8];
                    dot += qv[8 * c8 + 0] * bflo(u.x) + qv[8 * c8 + 1] * bfhi(u.x) + qv[8 * c8 + 2] * bflo(u.y) + qv[8 * c8 + 3] * bfhi(u.y)
                         + qv[8 * c8 + 4] * bflo(u.z) + qv[8 * c8 + 5] * bfhi(u.z) + qv[8 * c8 + 6] * bflo(u.w) + qv[8 * c8 + 7] * bfhi(u.w); }
                s[jj] = ok[jj] ? dot : -__builtin_inff(); }
            const float mb = wave_max(fmaxf(s[0], fmaxf(s[1], s[2])));
            const float p0 = ok[0] ? __expf(s[0] - mb) : 0.f, p1 = ok[1] ? __expf(s[1] - mb) : 0.f, p2 = ok[2] ? __expf(s[2] - mb) : 0.f;
            const float lb = wave_sum(p0 + p1 + p2);
            float ob = 0.f;
#pragma unroll 1
            for (int j8 = 0; j8 < 64; j8 += 8) { float vv[8];
#pragma unroll
                for (int u = 0; u < 8; ++u) { int kp = t - (j8 + u) * d; kp = kp < 0 ? 0 : kp; vv[u] = bf2f(vb[(size_t)kp * NPROJ]); }
#pragma unroll
                for (int u = 0; u < 8; ++u) ob += __builtin_bit_cast(float, __builtin_amdgcn_readlane(__builtin_bit_cast(int, p0), j8 + u)) * vv[u]; }
#pragma unroll 1
            for (int j8 = 0; j8 < 64; j8 += 8) { float vv[8];
#pragma unroll
                for (int u = 0; u < 8; ++u) { int kp = t - (64 + j8 + u) * d; kp = kp < 0 ? 0 : kp; vv[u] = bf2f(vb[(size_t)kp * NPROJ]); }
#pragma unroll
                for (int u = 0; u < 8; ++u) ob += __builtin_bit_cast(float, __builtin_amdgcn_readlane(__builtin_bit_cast(int, p1), j8 + u)) * vv[u]; }
            { int kp = t - 128 * d; kp = kp < 0 ? 0 : kp; ob += __builtin_bit_cast(float, __builtin_amdgcn_readlane(__builtin_bit_cast(int, p2), 0)) * bf2f(vb[(size_t)kp * NPROJ]); }
            const float Mn = fmaxf(M, mb), sa = __expf(M - Mn), sb = __expf(mb - Mn);
            O = O * sa + ob * sb; L = L * sa + lb * sb; M = Mn;
        }
        MIX[(size_t)t * DMIX + 2048 + h * 64 + lane] = (bf16)f2bf(O / L);
    }
}

__device__ __forceinline__ void p5_gate_norm(const Args& a, Frame& F) {
    const bf16* PROJ = (const bf16*)(a.ws + WS_PROJ); const bf16* XBC = (const bf16*)(a.ws + WS_XBC); const float* YS = (const float*)(a.ws + WS_YS); bf16* MIX = (bf16*)(a.ws + WS_MIX);
    const float* Dsk = (const float*)a.in[8]; const float* snw = (const float*)a.in[9];
    const int lane = F.lane; const float dsk = Dsk[lane >> 1];
    for (int t = F.gw; t < T; t += F.NGW) {
        const f32x4* yp = (const f32x4*)(YS + (size_t)t * D + 32 * lane); const v4u* xp = (const v4u*)(XBC + (size_t)t * NCONV + 32 * lane); const v4u* zp = (const v4u*)(PROJ + (size_t)t * NPROJ + 32 * lane);
        float v[32]; float ss = 0.f;
#pragma unroll
        for (int j = 0; j < 4; ++j) { const v4u xu = xp[j], zu = zp[j]; const f32x4 y0 = yp[2 * j], y1 = yp[2 * j + 1];
            v[8 * j + 0] = (y0.x + dsk * bflo(xu.x)) * silu(bflo(zu.x)); v[8 * j + 1] = (y0.y + dsk * bfhi(xu.x)) * silu(bfhi(zu.x));
            v[8 * j + 2] = (y0.z + dsk * bflo(xu.y)) * silu(bflo(zu.y)); v[8 * j + 3] = (y0.w + dsk * bfhi(xu.y)) * silu(bfhi(zu.y));
            v[8 * j + 4] = (y1.x + dsk * bflo(xu.z)) * silu(bflo(zu.z)); v[8 * j + 5] = (y1.y + dsk * bfhi(xu.z)) * silu(bfhi(zu.z));
            v[8 * j + 6] = (y1.z + dsk * bflo(xu.w)) * silu(bflo(zu.w)); v[8 * j + 7] = (y1.w + dsk * bfhi(xu.w)) * silu(bfhi(zu.w)); }
#pragma unroll
        for (int i = 0; i < 32; ++i) ss += v[i] * v[i];
        ss = row16_sum(ss);
        const float rstd = 1.0f / sqrtf(ss * (1.0f / 512.0f) + EPS);
        const f32x4* wp = (const f32x4*)(snw + 32 * lane); v4u* op = (v4u*)(MIX + (size_t)t * DMIX + 32 * lane);
#pragma unroll
        for (int j = 0; j < 4; ++j) { const f32x4 w0 = wp[2 * j], w1 = wp[2 * j + 1]; v4u u;
            u.x = pk2(v[8 * j + 0] * rstd * w0.x, v[8 * j + 1] * rstd * w0.y); u.y = pk2(v[8 * j + 2] * rstd * w0.z, v[8 * j + 3] * rstd * w0.w);
            u.z = pk2(v[8 * j + 4] * rstd * w1.x, v[8 * j + 5] * rstd * w1.y); u.w = pk2(v[8 * j + 6] * rstd * w1.z, v[8 * j + 7] * rstd * w1.w); op[j] = u; }
    }
}

__device__ __forceinline__ void p7_router(const Args& a, Frame& F) {
    const float* hres = a.out; const float* n2w = (const float*)a.in[13]; bf16* HN = (bf16*)(a.ws + WS_HN);
    const float* Wgr = (const float*)a.in[14]; const float* bgr = (const float*)a.in[15]; const float* Wer = (const float*)a.in[16]; const float* ber = (const float*)a.in[17];
    int* EID = (int*)(a.ws + WS_EID); float* GATE = (float*)(a.ws + WS_GATE); int* POS = (int*)(a.ws + WS_POS); unsigned* cnt = (unsigned*)(F.ctl + CW_CNT);
    const int lane = F.lane;
    for (int t = F.gw; t < T; t += F.NGW) {
        const GAS f32x4* xr = (const GAS f32x4*)(hres + (size_t)t * D) + lane; const GAS f32x4* wr = (const GAS f32x4*)n2w + lane;
        f32x4 v[8]; float s = 0.f;
#pragma unroll
        for (int j = 0; j < 8; ++j) { v[j] = xr[64 * j]; s += (v[j].x * v[j].x + v[j].y * v[j].y) + (v[j].z * v[j].z + v[j].w * v[j].w); }
        const float rstd = 1.0f / sqrtf(wave_sum(s) * (1.0f / D) + EPS);
        GAS unsigned long long* o8 = (GAS unsigned long long*)(HN + (size_t)t * D) + lane;
#pragma unroll
        for (int j = 0; j < 8; ++j) { v[j] = v[j] * rstd * wr[64 * j]; o8[64 * j] = (unsigned long long)pk2(v[j].x, v[j].y) | ((unsigned long long)pk2(v[j].z, v[j].w) << 32); }
        float gl[8];
#pragma unroll
        for (int c = 0; c < 8; ++c) gl[c] = 0.f;
#pragma unroll
        for (int j = 0; j < 8; ++j)
#pragma unroll
            for (int i = 0; i < 4; ++i) { const int k = 4 * lane + 256 * j + i; const f32x4 w0 = *(const f32x4*)(Wgr + (size_t)k * 8), w1 = *(const f32x4*)(Wgr + (size_t)k * 8 + 4); const float hv = v[j][i];
                gl[0] += hv * w0.x; gl[1] += hv * w0.y; gl[2] += hv * w0.z; gl[3] += hv * w0.w; gl[4] += hv * w1.x; gl[5] += hv * w1.y; gl[6] += hv * w1.z; gl[7] += hv * w1.w; }
        float gmax = -__builtin_inff(); int gi = 0;
#pragma unroll
        for (int c = 0; c < 8; ++c) { gl[c] = wave_sum(gl[c]) + bgr[c]; if (gl[c] > gmax) { gmax = gl[c]; gi = c; } }
        float gsum = 0.f;
#pragma unroll
        for (int c = 0; c < 8; ++c) gsum += expf(gl[c] - gmax);
        const float gval = 1.0f / gsum;
        gi = __builtin_amdgcn_readfirstlane(gi);
        const float* We = Wer + (size_t)gi * D * 8;
        float el[8];
#pragma unroll
        for (int c = 0; c < 8; ++c) el[c] = 0.f;
#pragma unroll
        for (int j = 0; j < 8; ++j)
#pragma unroll
            for (int i = 0; i < 4; ++i) { const int k = 4 * lane + 256 * j + i; const f32x4 w0 = *(const f32x4*)(We + (size_t)k * 8), w1 = *(const f32x4*)(We + (size_t)k * 8 + 4); const float hv = v[j][i];
                el[0] += hv * w0.x; el[1] += hv * w0.y; el[2] += hv * w0.z; el[3] += hv * w0.w; el[4] += hv * w1.x; el[5] += hv * w1.y; el[6] += hv * w1.z; el[7] += hv * w1.w; }
        float e1 = -__builtin_inff(); int i1 = 0;
#pragma unroll
        for (int c = 0; c < 8; ++c) { el[c] = wave_sum(el[c]) + ber[gi * 8 + c]; if (el[c] > e1) { e1 = el[c]; i1 = c; } }
        float e2 = -__builtin_inff(); int i2 = 0;
#pragma unroll
        for (int c = 0; c < 8; ++c) { if (c != i1 && el[c] > e2) { e2 = el[c]; i2 = c; } }
        const float r = expf(e2 - e1); const float w1 = 1.0f / (1.0f + r), w2 = r / (1.0f + r);
        if (lane == 0) { const int ea = gi * 8 + i1, eb = gi * 8 + i2;
            const unsigned pa = atomicAdd(cnt + ea, 1u), pb = atomicAdd(cnt + eb, 1u);
            EID[2 * t] = ea; EID[2 * t + 1] = eb; GATE[2 * t] = gval * w1; GATE[2 * t + 1] = gval * w2; POS[2 * t] = (int)pa; POS[2 * t + 1] = (int)pb; }
    }
}

__device__ __forceinline__ void p8_offsets(Frame& F) {
    LAS int* tab = (LAS int*)(F.lds + TAB_OFF);
    const unsigned* cnt = (const unsigned*)(F.ctl + CW_CNT);
    if (F.tid < 64) { const int c = (int)__hip_atomic_load(cnt + F.tid, __ATOMIC_RELAXED, __HIP_MEMORY_SCOPE_AGENT); tab[128 + F.tid] = c; tab[192 + F.tid] = (c + 255) & ~255; }
    __syncthreads();
    if (F.tid == 0) { int run = 0; for (int e = 0; e < 64; ++e) { tab[e] = run; run += tab[192 + e]; } tab[64] = run; }
    __syncthreads();
}
__device__ __forceinline__ void p8_gather(const Args& a, Frame& F) {
    p8_offsets(F);
    LAS int* tab = (LAS int*)(F.lds + TAB_OFF);
    const int R = tab[64];
    int* TILE = (int*)(a.ws + WS_TILE);
    if (blockIdx.x == 0) {
        for (int pm = F.tid; pm < R / 256; pm += NWAVES * 64) { int e = 0; for (int q = 1; q < 64; ++q) if (tab[q] <= pm * 256) e = q; TILE[pm] = e; }
        if (F.tid == 0) TILE[255] = R / 256;
    }
    const bf16* HN = (const bf16*)(a.ws + WS_HN); bf16* XG = (bf16*)(a.ws + WS_XG);
    const int* EID = (const int*)(a.ws + WS_EID); const int* POS = (const int*)(a.ws + WS_POS); int* DEST = (int*)(a.ws + WS_DEST);
    for (int as = F.gw; as < 2 * T; as += F.NGW) {
        const int e = EID[as], dest = tab[e] + POS[as];
        if (F.lane == 0) DEST[as] = dest;
        const v4u* src = (const v4u*)(HN + (size_t)(as >> 1) * D) + F.lane; v4u* dst = (v4u*)(XG + (size_t)dest * D) + F.lane;
#pragma unroll
        for (int j = 0; j < 4; ++j) dst[64 * j] = src[64 * j];
    }
    for (int r = F.gw; r < R; r += F.NGW) {
        int e = 0; for (int q = 1; q < 64; ++q) if (tab[q] <= r) e = q;
        if (r - tab[e] >= tab[128 + e]) { v4u* dst = (v4u*)(XG + (size_t)r * D) + F.lane; const v4u z = {0u, 0u, 0u, 0u};
#pragma unroll
            for (int j = 0; j < 4; ++j) dst[64 * j] = z; }
    }
}
__device__ __forceinline__ int moe_tiles_to_lds(const Args& a, Frame& F) {
    LAS int* tab = (LAS int*)(F.lds + TAB_OFF); const int* TILE = (const int*)(a.ws + WS_TILE);
    if (F.tid < 256) tab[F.tid] = TILE[F.tid];
    __syncthreads();
    return __builtin_amdgcn_readfirstlane(tab[255]);
}

__device__ __forceinline__ void p11_combine(const Args& a, Frame& F) {
    const bf16* Y = (const bf16*)(a.ws + WS_Y); const int* DEST = (const int*)(a.ws + WS_DEST); const float* GATE = (const float*)(a.ws + WS_GATE); float* out = a.out;
    for (int t = F.gw; t < T; t += F.NGW) {
        const int d0 = DEST[2 * t], d1 = DEST[2 * t + 1]; const float g0 = GATE[2 * t], g1 = GATE[2 * t + 1];
        GAS f32x4* o = (GAS f32x4*)(out + (size_t)t * D) + F.lane;
        const GAS unsigned long long* y0 = (const GAS unsigned long long*)(Y + (size_t)d0 * D) + F.lane; const GAS unsigned long long* y1 = (const GAS unsigned long long*)(Y + (size_t)d1 * D) + F.lane;
#pragma unroll
        for (int j = 0; j < 8; ++j) { f32x4 v = o[64 * j]; const unsigned long long u0 = y0[64 * j], u1 = y1[64 * j];
            v.x += g0 * bflo((unsigned)u0) + g1 * bflo((unsigned)u1); v.y += g0 * bfhi((unsigned)u0) + g1 * bfhi((unsigned)u1);
            v.z += g0 * bflo((unsigned)(u0 >> 32)) + g1 * bflo((unsigned)(u1 >> 32)); v.w += g0 * bfhi((unsigned)(u0 >> 32)) + g1 * bfhi((unsigned)(u1 >> 32));
            o[64 * j] = v; }
    }
}

constexpr int NPHASE = 12;
__global__ void __launch_bounds__(NWAVES * 64, 2) hymba_fwd(Args args) {
    extern __shared__ __attribute__((aligned(16))) unsigned char lds[];
    Frame F;
    F.lds = (LAS unsigned char*)lds;
    F.MISC = (volatile LAS unsigned*)(F.lds + MISC_OFF);
    F.tid = threadIdx.x; F.lane = F.tid & 63; F.wave = __builtin_amdgcn_readfirstlane(F.tid >> 6);
    F.G = gridDim.x; { const int bx = blockIdx.x; F.vcu = (F.G % 8 == 0) ? (bx % 8) * (F.G / 8) + bx / 8 : bx; }
    F.gw = F.vcu * NWAVES + F.wave; F.NGW = F.G * NWAVES;
    F.ctl = (gu32*)(args.ws + WS_CTL);
    for (int u = F.tid; u < (LDS_BYTES - LDSCTL_OFF) / 4; u += NWAVES * 64) ((LAS unsigned*)(F.lds + LDSCTL_OFF))[u] = 0u;
    __syncthreads();
    const int lo = args.ph_lo, hi = args.ph_hi;
    const bool fused = (hi - lo) > 1;
    XcdBarrier bar; bar.bar = (unsigned*)(F.ctl + CW_BAR); bar.x = 0; bar.st = nullptr;
    if (fused) bar = xcd_barrier_post((unsigned*)(F.ctl + CW_BAR), F.MISC + 8);
#define IN(k) (lo <= (k) && (k) < hi)
#define SEAM(k) do { if (IN(k) && IN((k) + 1)) xcd_barrier(bar); } while (0)

    if (IN(0)) { p0_prologue(args, F); SEAM(0); }
    if (IN(1)) {
        pg8::Gemm g{(const pg8::bf16_t*)(args.ws + WS_HN), (const pg8::bf16_t*)(args.ws + WS_W1T), T, NPROJ, D}; pg8::StaticOrder S; S.init(T, NPROJ, F.G, (int)blockIdx.x);
        pg8::EpiBf16<0> E{(pg8::bf16_t*)(args.ws + WS_PROJ), NPROJ, nullptr, 0, 0, 1.f};
        pg8::gemm_phase<pg8::EpiBf16<0>, pg8::StaticOrder, true, true>(F.lds + RING_OFF, g, S, E);
        SEAM(1);
    }
    if (IN(2)) { p2_postproj(args, F); SEAM(2); }
    if (IN(3)) { p3_ssd_seq(args, F); p3_attn_naive(args, F); SEAM(3); }
    if (IN(4)) { SEAM(4); }
    if (IN(5)) { p5_gate_norm(args, F); SEAM(5); }
    if (IN(6)) {
        pg8::Gemm g{(const pg8::bf16_t*)(args.ws + WS_MIX), (const pg8::bf16_t*)(args.ws + WS_WOT), T, D, DMIX}; pg8::StaticOrder S; S.init(T, D, F.G, (int)blockIdx.x);
        pg8::EpiResF32 E{(const float*)args.in[0], args.out, D};
        pg8::gemm_phase<pg8::EpiResF32, pg8::StaticOrder, true, true>(F.lds + RING_OFF, g, S, E);
        SEAM(6);
    }
    if (IN(7)) { p7_router(args, F); SEAM(7); }
    if (IN(8)) { p8_gather(args, F); SEAM(8); }
    if (IN(9)) {
        const int ntiles = moe_tiles_to_lds(args, F);
        pg8::Gemm g{(const pg8::bf16_t*)(args.ws + WS_XG), (const pg8::bf16_t*)(args.ws + WS_WGU), 0, 2048, D};
        pg8::MoeOrder S{(const LAS int*)(F.lds + TAB_OFF), ntiles, 8, F.G, (int)blockIdx.x, (size_t)2048 * D * 2};
        pg8::EpiSwiglu E{(pg8::bf16_t*)(args.ws + WS_HID), DEXP};
        pg8::gemm_phase<pg8::EpiSwiglu, pg8::MoeOrder, true, true>(F.lds + RING_OFF, g, S, E);
        SEAM(9);
    }
    if (IN(10)) {
        const int ntiles = moe_tiles_to_lds(args, F);
        pg8::Gemm g{(const pg8::bf16_t*)(args.ws + WS_HID), (const pg8::bf16_t*)(args.ws + WS_WD), 0, D, DEXP};
        pg8::MoeOrder S{(const LAS int*)(F.lds + TAB_OFF), ntiles, 8, F.G, (int)blockIdx.x, (size_t)D * DEXP * 2};
        pg8::EpiBf16<0> E{(pg8::bf16_t*)(args.ws + WS_Y), D, nullptr, 0, 0, 1.f};
        pg8::gemm_phase<pg8::EpiBf16<0>, pg8::MoeOrder, true, true>(F.lds + RING_OFF, g, S, E);
        SEAM(10);
    }
    if (IN(11)) { p11_combine(args, F); }
#undef IN
#undef SEAM
}

#ifndef ONE_LAUNCH
#define ONE_LAUNCH 0
#endif
extern "C" void kernel_launch(void* const* d_in, const int* in_sizes, int n_in, void* d_out, int out_size, void* d_ws, size_t ws_size, hipStream_t stream) {
    static int grid = 0;
    if (grid == 0) {
        if (n_in != 21 || out_size != T * D || ws_size < WS_END) { fprintf(stderr, "kernel_launch: unexpected shapes (n_in %d, out %d, ws %zu)\n", n_in, out_size, ws_size); grid = -1; return; }
        int dev = 0, cus = 0, per_cu = 0;
        if (hipGetDevice(&dev) != hipSuccess || hipDeviceGetAttribute(&cus, hipDeviceAttributeMultiprocessorCount, dev) != hipSuccess) { grid = -1; return; }
        if (hipFuncSetAttribute((const void*)hymba_fwd, hipFuncAttributeMaxDynamicSharedMemorySize, LDS_BYTES) != hipSuccess) { fprintf(stderr, "kernel_launch: hipFuncSetAttribute failed\n"); grid = -1; return; }
        if (hipOccupancyMaxActiveBlocksPerMultiprocessor(&per_cu, (const void*)hymba_fwd, NWAVES * 64, LDS_BYTES) != hipSuccess || per_cu < 1) { fprintf(stderr, "kernel_launch: occupancy query says %d\n", per_cu); }
        (void)hipGetLastError();
        grid = cus;
    }
    if (grid < 0) return;
    if (hipMemsetAsync((char*)d_ws + WS_CTL, 0, CTL_ZERO_BYTES, stream) != hipSuccess) return;
    Args a{};
    for (int i = 0; i < 21; ++i) a.in[i] = d_in[i];
    a.out = (float*)d_out; a.ws = (unsigned char*)d_ws;
#if ONE_LAUNCH
    a.ph_lo = 0; a.ph_hi = NPHASE;
    hipLaunchKernelGGL(hymba_fwd, dim3(grid), dim3(NWAVES * 64), LDS_BYTES, stream, a);
#else
    for (int ph = 0; ph < NPHASE; ++ph) { if (ph == 4) continue; a.ph_lo = ph; a.ph_hi = ph + 1; hipLaunchKernelGGL(hymba_fwd, dim3(grid), dim3(NWAVES * 64), LDS_BYTES, stream, a); }
#endif
}
```

```cpp
#include <hip/hip_runtime.h>
#include <cstdio>
#include <cstdint>
#include <cmath>
namespace pg8 {
#define PG8_LAS __attribute__((address_space(3)))
typedef unsigned short bf16_t;
typedef short bf16x8 __attribute__((ext_vector_type(8)));
typedef float f32x4 __attribute__((ext_vector_type(4)));
typedef unsigned u32x4 __attribute__((ext_vector_type(4)));
constexpr int BM = 256, BK = 64, HALF = 128, HTB = HALF * BK * 2  , STAGE_BYTES = 8 * HTB, NXCD = 8, WGM = 8;

__host__ __device__ __forceinline__ int lds_byte(int r, int c) { const int st = (r >> 4) * 2 + (c >> 5), rr = r & 15, cc = c & 31, ob = rr * 64 + cc * 2; return st * 1024 + (ob ^ (((ob >> 9) & 1) << 5)); }
__host__ __device__ __forceinline__ void stage_rc(int b, int& R, int& C) { const int st = b / 1024, sb = b % 1024, swz = sb ^ (((sb >> 9) & 1) << 5); R = (st >> 1) * 16 + swz / 64; C = (st & 1) * 32 + (swz % 64) / 2; }
__host__ __device__ __forceinline__ int perm32(int rho) { const int n = rho >> 4, i = rho & 15; return 8 * (i >> 2) + 4 * n + (i & 3); }

struct Unit { int pm, pn; };
struct Gemm { const bf16_t* A; const bf16_t* Bt; int M, N, K; };

struct StaticOrder {
    int nM, nN, nwg, G, c;
    __host__ __device__ void init(int M, int N, int G_, int c_) { nM = M / BM; nN = N / BM; nwg = nM * nN; G = G_; c = c_; }
    __host__ __device__ bool next(int i, Unit& u) const {
        const long L = (long)i * G + c; if (L >= nwg) return false;
        int wgid = (int)L; { const int q = nwg / NXCD, r = nwg % NXCD, xcd = wgid % NXCD, off = wgid / NXCD; wgid = (xcd < r ? xcd * (q + 1) : r * (q + 1) + (xcd - r) * q) + off; }
        const int nig = WGM * nN, gid = wgid / nig, fm = gid * WGM, gsz = (nM - fm) < WGM ? (nM - fm) : WGM;
        u.pm = fm + ((wgid % nig) % gsz); u.pn = (wgid % nig) / gsz; return true;
    }
    __device__ __forceinline__ size_t boff(const Unit&) const { return 0; }
    __device__ __forceinline__ void a_ready(const Unit&) const {}
    __device__ __forceinline__ void done(const Unit&) const {}
};

__device__ __forceinline__ unsigned cvt_pk_bf16(float lo, float hi) { unsigned r; asm volatile("v_cvt_pk_bf16_f32 %0, %1, %2" : "=v"(r) : "v"(lo), "v"(hi)); return r; }
typedef float f32x2 __attribute__((ext_vector_type(2)));
__device__ __forceinline__ f32x2 gelu_pk(f32x2 v) {
    const f32x2 av = __builtin_elementwise_abs(v), d = av * 0.2316418882f + 1.0f;
    f32x2 t; t.x = __builtin_amdgcn_rcpf(d.x); t.y = __builtin_amdgcn_rcpf(d.y);
    f32x2 q = t * 0.5307027145f + (-0.7265760135f); q = q * t + 0.7107068705f; q = q * t + (-0.142248368f); q = q * t + 0.127414796f; q = q * t;
    const f32x2 s = (v * v) * (-0.72134752044f);
    f32x2 e; e.x = __builtin_amdgcn_exp2f(s.x); e.y = __builtin_amdgcn_exp2f(s.y);
    const f32x2 m = v * (q * e), r = v - m;
    f32x2 o; o.x = v.x < 0.f ? m.x : r.x; o.y = v.y < 0.f ? m.y : r.y; return o;
}

template <int ACT  > struct EpiBf16 {
    static constexpr bool PERM = true, AFTER_DRAIN = false; static_assert(ACT == 0 || ACT == 1, "EpiBf16: ACT is 0 (none) or 1 (gelu_pk)");
    bf16_t* O; int ldc; const float* bias; int split_cols; size_t split_stride; float scale0;
    __device__ __forceinline__ void operator()(const f32x4 (&acc)[2][2][4][2], const Unit& u, int wr, int wc, int fr, int fq) const {
        const int row0 = u.pm * BM + wr * 64 + fr; int colt = u.pn * BM; bf16_t* base = O;
        float sc = 1.f; if (split_cols) { const int t = colt / split_cols; base += (size_t)t * split_stride; colt -= t * split_cols; if (t == 0) sc = scale0; }
        const int col0 = colt + wc * 32 + 8 * fq, bcol0 = u.pn * BM + wc * 32 + 8 * fq;
        f32x4 bv[2][2];
#pragma unroll
        for (int bj = 0; bj < 2; ++bj)
#pragma unroll
            for (int n = 0; n < 2; ++n) bv[bj][n] = bias ? *(const f32x4*)(bias + bcol0 + bj * HALF + 4 * n) : (f32x4){0.f, 0.f, 0.f, 0.f};
#pragma unroll
        for (int ai = 0; ai < 2; ++ai)
#pragma unroll
            for (int m = 0; m < 4; ++m) { bf16_t* rowp = base + (size_t)(row0 + ai * HALF + m * 16) * ldc + col0;
#pragma unroll
                for (int bj = 0; bj < 2; ++bj) { f32x4 v0 = acc[ai][bj][m][0] + bv[bj][0], v1 = acc[ai][bj][m][1] + bv[bj][1];
                    if (ACT == 1) { f32x2 a = gelu_pk((f32x2){v0[0], v0[1]}), b = gelu_pk((f32x2){v0[2], v0[3]}), c = gelu_pk((f32x2){v1[0], v1[1]}), d = gelu_pk((f32x2){v1[2], v1[3]});
                        v0 = (f32x4){a.x, a.y, b.x, b.y}; v1 = (f32x4){c.x, c.y, d.x, d.y}; }
                    v0 = v0 * sc; v1 = v1 * sc; u32x4 w; w.x = cvt_pk_bf16(v0[0], v0[1]); w.y = cvt_pk_bf16(v0[2], v0[3]); w.z = cvt_pk_bf16(v1[0], v1[1]); w.w = cvt_pk_bf16(v1[2], v1[3]);
                    *(u32x4*)(rowp + bj * HALF) = w; } }
    }
};
__device__ __forceinline__ float silu_f(float g) { return g * __builtin_amdgcn_rcpf(1.0f + __expf(-g)); }
struct EpiResF32 {
    static constexpr bool PERM = false, AFTER_DRAIN = false;
    const float* base; float* out; int ldc;
    __device__ __forceinline__ void operator()(const f32x4 (&acc)[2][2][4][2], const Unit& u, int wr, int wc, int fr, int fq) const {
        const int row0 = u.pm * BM + wr * 64 + fr, col0 = u.pn * BM + wc * 32 + 4 * fq;
#pragma unroll
        for (int ai = 0; ai < 2; ++ai)
#pragma unroll
            for (int m = 0; m < 4; ++m) { const size_t off = (size_t)(row0 + ai * HALF + m * 16) * ldc + col0;
#pragma unroll
                for (int bj = 0; bj < 2; ++bj)
#pragma unroll
                    for (int n = 0; n < 2; ++n) { const f32x4 b = *(const f32x4*)(base + off + bj * HALF + n * 16); *(f32x4*)(out + off + bj * HALF + n * 16) = b + acc[ai][bj][m][n]; }
                asm volatile("" ::: "memory"); }
    }
};
struct EpiSwiglu {
    static constexpr bool PERM = true, AFTER_DRAIN = false;
    bf16_t* O; int ldc;
    __device__ __forceinline__ void operator()(const f32x4 (&acc)[2][2][4][2], const Unit& u, int wr, int wc, int fr, int fq) const {
        const int row0 = u.pm * BM + wr * 64 + fr, col0 = u.pn * HALF + wc * 32 + 8 * fq;
#pragma unroll
        for (int ai = 0; ai < 2; ++ai)
#pragma unroll
            for (int m = 0; m < 4; ++m) { bf16_t* rowp = O + (size_t)(row0 + ai * HALF + m * 16) * ldc + col0;
                const f32x4 g0 = acc[ai][0][m][0], g1 = acc[ai][0][m][1], u0 = acc[ai][1][m][0], u1 = acc[ai][1][m][1];
                u32x4 w; w.x = cvt_pk_bf16(silu_f(g0[0]) * u0[0], silu_f(g0[1]) * u0[1]); w.y = cvt_pk_bf16(silu_f(g0[2]) * u0[2], silu_f(g0[3]) * u0[3]);
                w.z = cvt_pk_bf16(silu_f(g1[0]) * u1[0], silu_f(g1[1]) * u1[1]); w.w = cvt_pk_bf16(silu_f(g1[2]) * u1[2], silu_f(g1[3]) * u1[3]);
                *(u32x4*)rowp = w; }
    }
};
__device__ __forceinline__ float clamp8_pg(float x) { return __builtin_amdgcn_fmed3f(x, -448.f, 448.f); }
__device__ __forceinline__ unsigned fp8x4_pg(float a, float b, float c, float d) { int w = 0; w = __builtin_amdgcn_cvt_pk_fp8_f32(clamp8_pg(a), clamp8_pg(b), w, false); w = __builtin_amdgcn_cvt_pk_fp8_f32(clamp8_pg(c), clamp8_pg(d), w, true); return (unsigned)w; }
struct EpiSwiglu8 {
    static constexpr bool PERM = true, AFTER_DRAIN = false;
    unsigned char* O; int ldc; const float* rs;
    __device__ __forceinline__ void operator()(const f32x4 (&acc)[2][2][4][2], const Unit& u, int wr, int wc, int fr, int fq) const {
        const int row0 = u.pm * BM + wr * 64 + fr, col0 = u.pn * HALF + wc * 32 + 8 * fq;
        float rsv[2][4];
#pragma unroll
        for (int ai = 0; ai < 2; ++ai)
#pragma unroll
            for (int m = 0; m < 4; ++m) rsv[ai][m] = rs[row0 + ai * HALF + m * 16];
#pragma unroll
        for (int ai = 0; ai < 2; ++ai)
#pragma unroll
            for (int m = 0; m < 4; ++m) { unsigned char* rowp = O + (size_t)(row0 + ai * HALF + m * 16) * ldc + col0; const float rr_ = rsv[ai][m];
                const f32x4 g0 = acc[ai][0][m][0] * rr_, g1 = acc[ai][0][m][1] * rr_, u0 = acc[ai][1][m][0] * rr_, u1 = acc[ai][1][m][1] * rr_;
                const unsigned long long w = (unsigned long long)fp8x4_pg(4.f * silu_f(g0[0]) * u0[0], 4.f * silu_f(g0[1]) * u0[1], 4.f * silu_f(g0[2]) * u0[2], 4.f * silu_f(g0[3]) * u0[3])
                    | ((unsigned long long)fp8x4_pg(4.f * silu_f(g1[0]) * u1[0], 4.f * silu_f(g1[1]) * u1[1], 4.f * silu_f(g1[2]) * u1[2], 4.f * silu_f(g1[3]) * u1[3]) << 32);
                *(unsigned long long*)rowp = w; }
    }
};
struct EpiFp8 {
    static constexpr bool PERM = true, AFTER_DRAIN = false;
    unsigned char* O; int ldc; float s;
    __device__ __forceinline__ void operator()(const f32x4 (&acc)[2][2][4][2], const Unit& u, int wr, int wc, int fr, int fq) const {
        const int row0 = u.pm * BM + wr * 64 + fr, col0 = u.pn * BM + wc * 32 + 8 * fq;
#pragma unroll
        for (int ai = 0; ai < 2; ++ai)
#pragma unroll
            for (int m = 0; m < 4; ++m) { unsigned char* rowp = O + (size_t)(row0 + ai * HALF + m * 16) * ldc + col0;
#pragma unroll
                for (int bj = 0; bj < 2; ++bj) { const f32x4 v0 = acc[ai][bj][m][0] * s, v1 = acc[ai][bj][m][1] * s;
                    *(unsigned long long*)(rowp + bj * HALF) = (unsigned long long)fp8x4_pg(v0[0], v0[1], v0[2], v0[3]) | ((unsigned long long)fp8x4_pg(v1[0], v1[1], v1[2], v1[3]) << 32); } }
    }
};
struct OneUnit {
    StaticOrder base; int idx;
    __device__ __forceinline__ bool next(int i, Unit& u) const { return i == 0 && base.next(idx, u); }
    __device__ __forceinline__ size_t boff(const Unit&) const { return 0; }
    __device__ __forceinline__ void a_ready(const Unit&) const {}
    __device__ __forceinline__ void done(const Unit&) const {}
};
struct MoeOrder {
    const PG8_LAS int* tile_e; int ntiles, nN, G, c; size_t estride;
    __device__ __forceinline__ bool next(int i, Unit& u) const { const long L = (long)i * G + c; if (L >= (long)ntiles * nN) return false; u.pm = (int)(L / nN); u.pn = (int)(L % nN); return true; }
    __device__ __forceinline__ size_t boff(const Unit& u) const { return (size_t)__builtin_amdgcn_readfirstlane(tile_e[u.pm]) * estride; }
    __device__ __forceinline__ void a_ready(const Unit&) const {}
    __device__ __forceinline__ void done(const Unit&) const {}
};
template <class Epi, class Sched, bool ALIGN_EPI = false, bool SP2 = false>
__device__ __forceinline__ void gemm_phase(PG8_LAS unsigned char* lds, const Gemm g, const Sched& S, const Epi& E) {
    int tid_ = threadIdx.x; asm volatile("" : "+v"(tid_));
    const int tid = tid_, wid = __builtin_amdgcn_readfirstlane(tid >> 6), lane = tid & 63, wr = wid >> 2, wc = wid & 3, fr = lane & 15, fq = lane >> 4;
    const int K = g.K, nt = K / BK;
    unsigned voffA[2], voffB[2];
#pragma unroll
    for (int i = 0; i < 2; ++i) { int R, C; stage_rc(tid * 16 + i * 8192, R, C); const int Rb = Epi::PERM ? ((R & ~31) + perm32(R & 31)) : R;
        voffA[i] = (unsigned)(R * K + C) * 2u; voffB[i] = (unsigned)(Rb * K + C) * 2u; }
    const size_t kstep = (size_t)(BK * 2);
    const size_t hstep = (size_t)HALF * K * 2;
    const size_t tstep = 2 * hstep;
    const unsigned ldsw = (unsigned)wid * 1024u;
    const int aoff = lds_byte(wr * 64 + fr, fq * 8), boff = lds_byte(wc * 32 + fr, fq * 8);
#define PG8_SA(b, h) (((b) * 2 + (h)) * HTB)
#define PG8_SB(b, h) ((4 + (b) * 2 + (h)) * HTB)
#define PG8_STAGE(bufoff, gbase, voff) do { _Pragma("unroll") for (int _i = 0; _i < 2; ++_i) \
        __builtin_amdgcn_global_load_lds((const unsigned*)((const char*)(gbase) + (voff)[_i]), (PG8_LAS unsigned*)(lds + (bufoff) + ldsw + _i * 8192), 16, 0, 0); } while (0)
#define PG8_LDA(dst, b, h) do { _Pragma("unroll") for (int m = 0; m < 4; ++m) _Pragma("unroll") for (int k = 0; k < 2; ++k) dst[m][k] = *(const PG8_LAS bf16x8*)(lds + PG8_SA(b, h) + aoff + m * 2048 + k * 1024); } while (0)
#define PG8_LDB(dst, b, h) do { _Pragma("unroll") for (int n = 0; n < 2; ++n) _Pragma("unroll") for (int k = 0; k < 2; ++k) dst[n][k] = *(const PG8_LAS bf16x8*)(lds + PG8_SB(b, h) + boff + n * 2048 + k * 1024); } while (0)
#define PG8_MMA(ai, bj, At, Bt) do { __builtin_amdgcn_s_setprio(1); _Pragma("unroll") for (int m = 0; m < 4; ++m) _Pragma("unroll") for (int n = 0; n < 2; ++n) _Pragma("unroll") for (int k = 0; k < 2; ++k) \
        acc[ai][bj][m][n] = __builtin_amdgcn_mfma_f32_16x16x32_bf16(Bt[n][k], At[m][k], acc[ai][bj][m][n], 0, 0, 0); __builtin_amdgcn_s_setprio(0); } while (0)
#define PG8_WAIT_V(n) asm volatile("s_waitcnt vmcnt(" #n ")" ::: "memory")
#define PG8_WAIT_L(n) asm volatile("s_waitcnt lgkmcnt(" #n ")" ::: "memory")
#define PG8_BAR __builtin_amdgcn_s_barrier()
#define PG8_SCHED __builtin_amdgcn_sched_barrier(0)
    Unit cur, nxt; int ui = 0;
    if (!S.next(0, cur)) return;
    f32x4 acc[2][2][4][2];
#pragma unroll
    for (int a = 0; a < 2; ++a)
#pragma unroll
        for (int b = 0; b < 2; ++b)
#pragma unroll
            for (int m = 0; m < 4; ++m)
#pragma unroll
                for (int n = 0; n < 2; ++n) acc[a][b][m][n] = (f32x4){0.f, 0.f, 0.f, 0.f};
    bf16x8 At[4][2], B0[2][2], B1[2][2];
    const char* cA = (const char*)g.A + (size_t)cur.pm * tstep; const char* cB = (const char*)g.Bt + S.boff(cur) + (size_t)cur.pn * tstep;
    S.a_ready(cur);
    if constexpr (SP2) {
        PG8_STAGE(PG8_SB(0, 0), cB, voffB); PG8_STAGE(PG8_SB(0, 1), cB + hstep, voffB); PG8_STAGE(PG8_SA(0, 0), cA, voffA); PG8_STAGE(PG8_SA(0, 1), cA + hstep, voffA);
        if (wr == 1) PG8_BAR;
        PG8_WAIT_V(2); PG8_BAR;
        PG8_STAGE(PG8_SB(1, 0), cB + kstep, voffB); PG8_STAGE(PG8_SA(1, 0), cA + kstep, voffA); PG8_STAGE(PG8_SB(1, 1), cB + hstep + kstep, voffB);
        PG8_WAIT_V(6); PG8_BAR;
    } else {
        PG8_STAGE(PG8_SB(0, 0), cB, voffB); PG8_STAGE(PG8_SA(0, 0), cA, voffA); PG8_STAGE(PG8_SB(0, 1), cB + hstep, voffB); PG8_STAGE(PG8_SA(0, 1), cA + hstep, voffA);
        if (wr == 1) PG8_BAR;
        PG8_WAIT_V(4); PG8_BAR;
        PG8_STAGE(PG8_SB(1, 0), cB + kstep, voffB); PG8_STAGE(PG8_SA(1, 0), cA + kstep, voffA); PG8_STAGE(PG8_SB(1, 1), cB + hstep + kstep, voffB);
        PG8_WAIT_V(6); PG8_BAR;
    }
    for (;;) {
        const bool has_next = S.next(ui + 1, nxt);
        const char* nA = has_next ? (const char*)g.A + (size_t)nxt.pm * tstep : cA; const char* nB = has_next ? (const char*)g.Bt + S.boff(nxt) + (size_t)nxt.pn * tstep : cB;
        for (int t = 0; t < nt; t += 2) {
            const bool last = (t == nt - 2);
            const char* a1 = cA + (size_t)(t + 1) * kstep;
            const char* a2 = last ? nA : cA + (size_t)(t + 2) * kstep; const char* b2 = last ? nB : cB + (size_t)(t + 2) * kstep;
            const char* a3 = a2 + kstep; const char* b3 = b2 + kstep;
            if (last && has_next) S.a_ready(nxt);
            if constexpr (SP2) {
            PG8_LDB(B0, 0, 0); PG8_LDB(B1, 0, 1); PG8_SCHED; PG8_LDA(At, 0, 0); PG8_STAGE(PG8_SA(1, 1), a1 + hstep, voffA);
            PG8_WAIT_V(8); PG8_WAIT_L(0); PG8_BAR; PG8_MMA(0, 0, At, B0); PG8_MMA(0, 1, At, B1); PG8_BAR; PG8_SCHED;
            PG8_LDA(At, 0, 1); PG8_STAGE(PG8_SB(0, 0), b2, voffB); PG8_STAGE(PG8_SB(0, 1), b2 + hstep, voffB); PG8_STAGE(PG8_SA(0, 0), a2, voffA);
            PG8_WAIT_V(8); PG8_WAIT_L(0); PG8_BAR; PG8_MMA(1, 0, At, B0); PG8_MMA(1, 1, At, B1); PG8_BAR; PG8_SCHED;
            PG8_LDB(B0, 1, 0); PG8_LDB(B1, 1, 1); PG8_SCHED; PG8_LDA(At, 1, 0); PG8_STAGE(PG8_SA(0, 1), a2 + hstep, voffA);
            PG8_WAIT_V(8); PG8_WAIT_L(0); PG8_BAR; PG8_MMA(0, 0, At, B0); PG8_MMA(0, 1, At, B1); PG8_BAR; PG8_SCHED;
            PG8_LDA(At, 1, 1); PG8_STAGE(PG8_SB(1, 0), b3, voffB); PG8_STAGE(PG8_SB(1, 1), b3 + hstep, voffB); PG8_STAGE(PG8_SA(1, 0), a3, voffA);
            PG8_WAIT_V(8); PG8_WAIT_L(0); PG8_BAR; PG8_MMA(1, 0, At, B0); PG8_MMA(1, 1, At, B1); PG8_BAR; PG8_SCHED;
            } else {
            PG8_LDB(B0, 0, 0); PG8_SCHED; PG8_LDA(At, 0, 0); PG8_STAGE(PG8_SA(1, 1), a1 + hstep, voffA);
            PG8_WAIT_L(8); PG8_BAR; PG8_WAIT_L(0); PG8_MMA(0, 0, At, B0); PG8_BAR; PG8_SCHED;
            PG8_LDB(B1, 0, 1); PG8_STAGE(PG8_SB(0, 0), b2, voffB);
            PG8_BAR; PG8_WAIT_L(0); PG8_MMA(0, 1, At, B1); PG8_BAR;
            PG8_LDA(At, 0, 1); PG8_STAGE(PG8_SA(0, 0), a2, voffA);
            PG8_BAR; PG8_WAIT_L(0); PG8_MMA(1, 0, At, B0); PG8_BAR; PG8_SCHED;
            PG8_STAGE(PG8_SB(0, 1), b2 + hstep, voffB);
            PG8_WAIT_V(6); PG8_BAR; PG8_MMA(1, 1, At, B1); PG8_BAR;
            PG8_LDB(B0, 1, 0); PG8_SCHED; PG8_LDA(At, 1, 0); PG8_STAGE(PG8_SA(0, 1), a2 + hstep, voffA);
            PG8_WAIT_L(8); PG8_BAR; PG8_WAIT_L(0); PG8_MMA(0, 0, At, B0); PG8_BAR; PG8_SCHED;
            PG8_LDB(B1, 1, 1); PG8_STAGE(PG8_SB(1, 0), b3, voffB);
            PG8_BAR; PG8_WAIT_L(0); PG8_MMA(0, 1, At, B1); PG8_BAR;
            PG8_LDA(At, 1, 1); PG8_STAGE(PG8_SA(1, 0), a3, voffA);
            PG8_BAR; PG8_WAIT_L(0); PG8_MMA(1, 0, At, B0); PG8_BAR; PG8_SCHED;
            PG8_STAGE(PG8_SB(1, 1), b3 + hstep, voffB);
            PG8_WAIT_V(6); PG8_BAR; PG8_MMA(1, 1, At, B1); PG8_BAR;
            }
        }
        if constexpr (ALIGN_EPI) { if (wr == 0) PG8_BAR; }
        if constexpr (!Epi::AFTER_DRAIN) { E(acc, cur, wr, wc, fr, fq); S.done(cur); }
        if (!has_next) break;
#pragma unroll
        for (int a = 0; a < 2; ++a)
#pragma unroll
            for (int b = 0; b < 2; ++b)
#pragma unroll
                for (int m = 0; m < 4; ++m)
#pragma unroll
                    for (int n = 0; n < 2; ++n) acc[a][b][m][n] = (f32x4){0.f, 0.f, 0.f, 0.f};
        cur = nxt; cA = nA; cB = nB; ++ui;
        if constexpr (ALIGN_EPI) { if (wr == 1) PG8_BAR; }
    }
    PG8_WAIT_V(0);
    if constexpr (!ALIGN_EPI) { if (wr == 0) PG8_BAR; }
    PG8_BAR;
    if constexpr (Epi::AFTER_DRAIN) { E.fused(acc, cur, wr, wc, fr, fq, lds, wid, lane); S.done(cur); }
#undef PG8_SA
#undef PG8_SB
#undef PG8_STAGE
#undef PG8_LDA
#undef PG8_LDB
#undef PG8_MMA
#undef PG8_WAIT_V
#undef PG8_WAIT_L
#undef PG8_BAR
#undef PG8_SCHED
}
typedef int v4i_t __attribute__((ext_vector_type(4))); typedef int v8i_t __attribute__((ext_vector_type(8)));
template <class Epi, class Sched, bool ALIGN_EPI = false, bool SP2 = false, bool BT = false>
__device__ __forceinline__ void gemm_phase8(PG8_LAS unsigned char* lds, const Gemm g, const Sched& S, const Epi& E, const int sW, const int sA) {
    int tid_ = threadIdx.x; asm volatile("" : "+v"(tid_));
    const int tid = tid_, wid = __builtin_amdgcn_readfirstlane(tid >> 6), lane = tid & 63, wr = wid >> 2, wc = wid & 3, fr = lane & 15, fq = lane >> 4;
    const int K = g.K, nt = K / BK;
    unsigned voffA[2], voffB[2];
#pragma unroll
    for (int i = 0; i < 2; ++i) { int R, C; stage_rc(tid * 16 + i * 8192, R, C); const int Rb = Epi::PERM ? ((R & ~31) + perm32(R & 31)) : R;
        voffA[i] = (unsigned)(R * K + C) * 2u; voffB[i] = BT ? (unsigned)(tid * 16 + i * 8192) : (unsigned)(Rb * K + C) * 2u; }
    const size_t kstep = (size_t)(BK * 2);
    const size_t kstepB = BT ? (size_t)HTB : kstep;
    const size_t hstep = (size_t)HALF * K * 2;
    const size_t tstep = 2 * hstep;
    const unsigned ldsw = (unsigned)wid * 1024u;
    const int aoff = lds_byte(wr * 64 + fr, fq * 8), boff = lds_byte(wc * 32 + fr, fq * 8);
    constexpr int aoff1d = 1024, boff1d = 1024;
#define PG8_SA(b, h) (((b) * 2 + (h)) * HTB)
#define PG8_SB(b, h) ((4 + (b) * 2 + (h)) * HTB)
#define PG8_STAGE(bufoff, gbase, voff) do { _Pragma("unroll") for (int _i = 0; _i < 2; ++_i) \
        __builtin_amdgcn_global_load_lds((const unsigned*)((const char*)(gbase) + (voff)[_i]), (PG8_LAS unsigned*)(lds + (bufoff) + ldsw + _i * 8192), 16, 0, 0); } while (0)
#define PG8_LDA(dst, b, h) do { _Pragma("unroll") for (int m = 0; m < 4; ++m) { const v4i_t lo_ = *(const PG8_LAS v4i_t*)(lds + PG8_SA(b, h) + aoff + m * 2048), hi_ = *(const PG8_LAS v4i_t*)(lds + PG8_SA(b, h) + aoff + aoff1d + m * 2048); dst[m] = __builtin_shufflevector(lo_, hi_, 0, 1, 2, 3, 4, 5, 6, 7); } } while (0)
#define PG8_LDB(dst, b, h) do { _Pragma("unroll") for (int n = 0; n < 2; ++n) { const v4i_t lo_ = *(const PG8_LAS v4i_t*)(lds + PG8_SB(b, h) + boff + n * 2048), hi_ = *(const PG8_LAS v4i_t*)(lds + PG8_SB(b, h) + boff + boff1d + n * 2048); dst[n] = __builtin_shufflevector(lo_, hi_, 0, 1, 2, 3, 4, 5, 6, 7); } } while (0)
#define PG8_MMA(ai, bj, At, Bt) do { __builtin_amdgcn_s_setprio(1); _Pragma("unroll") for (int m = 0; m < 4; ++m) _Pragma("unroll") for (int n = 0; n < 2; ++n) \
        asm volatile("v_mfma_scale_f32_16x16x128_f8f6f4 %0, %1, %2, %0, %3, %4 op_sel_hi:[0,0,0]" : "+v"(acc[ai][bj][m][n]) : "v"(Bt[n]), "v"(At[m]), "v"(sW), "v"(sA)); __builtin_amdgcn_s_setprio(0); } while (0)
#define PG8_WAIT_V(n) asm volatile("s_waitcnt vmcnt(" #n ")" ::: "memory")
#define PG8_WAIT_L(n) asm volatile("s_waitcnt lgkmcnt(" #n ")" ::: "memory")
#define PG8_BAR __builtin_amdgcn_s_barrier()
#define PG8_SCHED __builtin_amdgcn_sched_barrier(0)
    Unit cur, nxt; int ui = 0;
    if (!S.next(0, cur)) return;
    f32x4 acc[2][2][4][2];
#pragma unroll
    for (int a = 0; a < 2; ++a)
#pragma unroll
        for (int b = 0; b < 2; ++b)
#pragma unroll
            for (int m = 0; m < 4; ++m)
#pragma unroll
                for (int n = 0; n < 2; ++n) acc[a][b][m][n] = (f32x4){0.f, 0.f, 0.f, 0.f};
    v8i_t At[4], B0[2], B1[2];
    const char* cA = (const char*)g.A + (size_t)cur.pm * tstep; const char* cB = (const char*)g.Bt + S.boff(cur) + (size_t)cur.pn * tstep;
    S.a_ready(cur);
    if constexpr (SP2) {
        PG8_STAGE(PG8_SB(0, 0), cB, voffB); PG8_STAGE(PG8_SB(0, 1), cB + hstep, voffB); PG8_STAGE(PG8_SA(0, 0), cA, voffA); PG8_STAGE(PG8_SA(0, 1), cA + hstep, voffA);
        if (wr == 1) PG8_BAR;
        PG8_WAIT_V(2); PG8_BAR;
        PG8_STAGE(PG8_SB(1, 0), cB + kstepB, voffB); PG8_STAGE(PG8_SA(1, 0), cA + kstep, voffA); PG8_STAGE(PG8_SB(1, 1), cB + hstep + kstepB, voffB);
        PG8_WAIT_V(6); PG8_BAR;
    } else {
        PG8_STAGE(PG8_SB(0, 0), cB, voffB); PG8_STAGE(PG8_SA(0, 0), cA, voffA); PG8_STAGE(PG8_SB(0, 1), cB + hstep, voffB); PG8_STAGE(PG8_SA(0, 1), cA + hstep, voffA);
        if (wr == 1) PG8_BAR;
        PG8_WAIT_V(4); PG8_BAR;
        PG8_STAGE(PG8_SB(1, 0), cB + kstepB, voffB); PG8_STAGE(PG8_SA(1, 0), cA + kstep, voffA); PG8_STAGE(PG8_SB(1, 1), cB + hstep + kstepB, voffB);
        PG8_WAIT_V(6); PG8_BAR;
    }
    for (;;) {
        const bool has_next = S.next(ui + 1, nxt);
        const char* nA = has_next ? (const char*)g.A + (size_t)nxt.pm * tstep : cA; const char* nB = has_next ? (const char*)g.Bt + S.boff(nxt) + (size_t)nxt.pn * tstep : cB;
#pragma unroll 1
        for (int t = 0; t < nt; t += 2) {
            const bool last = (t == nt - 2);
            const char* a1 = cA + (size_t)(t + 1) * kstep;
            const char* a2 = last ? nA : cA + (size_t)(t + 2) * kstep; const char* b2 = last ? nB : cB + (size_t)(t + 2) * kstepB;
            const char* a3 = a2 + kstep; const char* b3 = b2 + kstepB;
            if (last && has_next) S.a_ready(nxt);
            if constexpr (SP2) {
            PG8_LDB(B0, 0, 0); PG8_LDB(B1, 0, 1); PG8_SCHED; PG8_LDA(At, 0, 0); PG8_STAGE(PG8_SA(1, 1), a1 + hstep, voffA);
            PG8_WAIT_V(8); PG8_WAIT_L(0); PG8_BAR; PG8_MMA(0, 0, At, B0); PG8_MMA(0, 1, At, B1); PG8_BAR; PG8_SCHED;
            PG8_LDA(At, 0, 1); PG8_STAGE(PG8_SB(0, 0), b2, voffB); PG8_STAGE(PG8_SB(0, 1), b2 + hstep, voffB); PG8_STAGE(PG8_SA(0, 0), a2, voffA);
            PG8_WAIT_V(8); PG8_WAIT_L(0); PG8_BAR; PG8_MMA(1, 0, At, B0); PG8_MMA(1, 1, At, B1); PG8_BAR; PG8_SCHED;
            PG8_LDB(B0, 1, 0); PG8_LDB(B1, 1, 1); PG8_SCHED; PG8_LDA(At, 1, 0); PG8_STAGE(PG8_SA(0, 1), a2 + hstep, voffA);
            PG8_WAIT_V(8); PG8_WAIT_L(0); PG8_BAR; PG8_MMA(0, 0, At, B0); PG8_MMA(0, 1, At, B1); PG8_BAR; PG8_SCHED;
            PG8_LDA(At, 1, 1); PG8_STAGE(PG8_SB(1, 0), b3, voffB); PG8_STAGE(PG8_SB(1, 1), b3 + hstep, voffB); PG8_STAGE(PG8_SA(1, 0), a3, voffA);
            PG8_WAIT_V(8); PG8_WAIT_L(0); PG8_BAR; PG8_MMA(1, 0, At, B0); PG8_MMA(1, 1, At, B1); PG8_BAR; PG8_SCHED;
            } else {
            PG8_LDB(B0, 0, 0); PG8_SCHED; PG8_LDA(At, 0, 0); PG8_STAGE(PG8_SA(1, 1), a1 + hstep, voffA);
            PG8_WAIT_L(8); PG8_BAR; PG8_WAIT_L(0); PG8_MMA(0, 0, At, B0); PG8_BAR; PG8_SCHED;
            PG8_LDB(B1, 0, 1); PG8_STAGE(PG8_SB(0, 0), b2, voffB);
            PG8_BAR; PG8_WAIT_L(0); PG8_MMA(0, 1, At, B1); PG8_BAR;
            PG8_LDA(At, 0, 1); PG8_STAGE(PG8_SA(0, 0), a2, voffA);
            PG8_BAR; PG8_WAIT_L(0); PG8_MMA(1, 0, At, B0); PG8_BAR; PG8_SCHED;
            PG8_STAGE(PG8_SB(0, 1), b2 + hstep, voffB);
            PG8_WAIT_V(6); PG8_BAR; PG8_MMA(1, 1, At, B1); PG8_BAR;
            PG8_LDB(B0, 1, 0); PG8_SCHED; PG8_LDA(At, 1, 0); PG8_STAGE(PG8_SA(0, 1), a2 + hstep, voffA);
            PG8_WAIT_L(8); PG8_BAR; PG8_WAIT_L(0); PG8_MMA(0, 0, At, B0); PG8_BAR; PG8_SCHED;
            PG8_LDB(B1, 1, 1); PG8_STAGE(PG8_SB(1, 0), b3, voffB);
            PG8_BAR; PG8_WAIT_L(0); PG8_MMA(0, 1, At, B1); PG8_BAR;
            PG8_LDA(At, 1, 1); PG8_STAGE(PG8_SA(1, 0), a3, voffA);
            PG8_BAR; PG8_WAIT_L(0); PG8_MMA(1, 0, At, B0); PG8_BAR; PG8_SCHED;
            PG8_STAGE(PG8_SB(1, 1), b3 + hstep, voffB);
            PG8_WAIT_V(6); PG8_BAR; PG8_MMA(1, 1, At, B1); PG8_BAR;
            }
        }
        asm volatile("s_nop 15\n\ts_nop 15" ::: "memory");
        if constexpr (ALIGN_EPI) { if (wr == 0) PG8_BAR; }
        if constexpr (!Epi::AFTER_DRAIN) { E(acc, cur, wr, wc, fr, fq); S.done(cur); }
        if (!has_next) break;
#pragma unroll
        for (int a = 0; a < 2; ++a)
#pragma unroll
            for (int b = 0; b < 2; ++b)
#pragma unroll
                for (int m = 0; m < 4; ++m)
#pragma unroll
                    for (int n = 0; n < 2; ++n) acc[a][b][m][n] = (f32x4){0.f, 0.f, 0.f, 0.f};
        cur = nxt; cA = nA; cB = nB; ++ui;
        if constexpr (ALIGN_EPI) { if (wr == 1) PG8_BAR; }
    }
    PG8_WAIT_V(0);
    if constexpr (!ALIGN_EPI) { if (wr == 0) PG8_BAR; }
    PG8_BAR;
    if constexpr (Epi::AFTER_DRAIN) { E.fused(acc, cur, wr, wc, fr, fq, lds, wid, lane); S.done(cur); }
#undef PG8_SA
#undef PG8_SB
#undef PG8_STAGE
#undef PG8_LDA
#undef PG8_LDB
#undef PG8_MMA
#undef PG8_WAIT_V
#undef PG8_WAIT_L
#undef PG8_BAR
#undef PG8_SCHED
}
}
#define GAS __attribute__((address_space(1)))
#define LAS __attribute__((address_space(3)))
typedef unsigned short bf16;
typedef unsigned v4u __attribute__((ext_vector_type(4)));
typedef float f32x4 __attribute__((ext_vector_type(4)));
typedef short bf16x8 __attribute__((ext_vector_type(8)));
typedef GAS unsigned gu32;
typedef GAS unsigned long long gu64;
#define RLX_AGENT __ATOMIC_RELAXED, __HIP_MEMORY_SCOPE_AGENT
#define LDS_WAIT() asm volatile("s_waitcnt lgkmcnt(0)" ::: "memory")
#define VM_WAIT() asm volatile("s_waitcnt vmcnt(0)" ::: "memory")
__device__ __forceinline__ unsigned long long rt() { return __builtin_amdgcn_s_memrealtime(); }
__device__ __forceinline__ unsigned f2bf(float f) { unsigned u = __builtin_bit_cast(unsigned, f); return (u + 0x7fffu + ((u >> 16) & 1u)) >> 16; }
__device__ __forceinline__ unsigned pk2(float lo, float hi) { return f2bf(lo) | (f2bf(hi) << 16); }

#define XB_TMO      128
#define XB_XCNT(j)  (256  + 64 * (j))
#define XB_XSUB(j)  (1280 + 64 * (j))
#define XB_XGEN(j)  (2304 + 64 * (j))
#define XB_TOP      3328
#define XB_TOPGEN   3392
#define XCD_BAR_WORDS 3456
#define XB_SPIN_CAP (1u << 18)

__device__ __forceinline__ unsigned xb_ld(unsigned* p)              { return __hip_atomic_load(p, __ATOMIC_RELAXED, __HIP_MEMORY_SCOPE_AGENT); }
__device__ __forceinline__ unsigned xb_add(unsigned* p, unsigned v) { return __hip_atomic_fetch_add(p, v, __ATOMIC_RELAXED, __HIP_MEMORY_SCOPE_AGENT); }
__device__ __forceinline__ unsigned xb_xcc_id() { return (unsigned)__builtin_amdgcn_s_getreg((3 << 11) | 20) & 0xFu; }
#define XB_SPIN(cond, bar) do { unsigned _sp = 0; while (cond) { __builtin_amdgcn_s_sleep(1); \
    if ((++_sp & 255u) == 0u) { if (xb_ld(&(bar)[XB_TMO])) break; if (_sp > XB_SPIN_CAP) { atomicAdd(&(bar)[XB_TMO], 1u); break; } } } } while (0)

struct XcdBarrier {
    unsigned* bar; unsigned x;
    volatile LAS unsigned* st;
};

__device__ __forceinline__ XcdBarrier xcd_barrier_post(unsigned* bar, volatile LAS unsigned* st) {
    XcdBarrier b; b.bar = bar; b.x = xb_xcc_id(); b.st = st;
    if (threadIdx.x == 0) (void)xb_add(&bar[XB_XCNT(b.x)], 1u);
    return b;
}
__device__ __forceinline__ void xcd_barrier_complete(unsigned* bar, unsigned x, unsigned& nloc, unsigned& nx) {
    const unsigned G = gridDim.x * gridDim.y * gridDim.z;
    unsigned sum, cnt, mine, sp = 0u;
    for (;;) {
        sum = 0u; cnt = 0u; mine = 0u;
#pragma unroll
        for (unsigned j = 0; j < 16; ++j) { const unsigned c = xb_ld(&bar[XB_XCNT(j)]); sum += c; cnt += (c > 0u) ? 1u : 0u; mine = (j == x) ? c : mine; }
        if (sum == G) break;
        __builtin_amdgcn_s_sleep(1);
        if ((++sp & 255u) == 0u) { if (xb_ld(&bar[XB_TMO])) break; if (sp > XB_SPIN_CAP) { atomicAdd(&bar[XB_TMO], 1u); break; } }
    }
    nloc = mine > 0u ? mine : 1u; nx = cnt > 0u ? cnt : 1u;
}

__device__ __forceinline__ void xcd_barrier(const XcdBarrier& b) {
    asm volatile("s_waitcnt vmcnt(0)" ::: "memory");
    __syncthreads();
    if (threadIdx.x == 0) {
        unsigned* bar = b.bar;
        __builtin_amdgcn_s_waitcnt(0);
        unsigned nloc = b.st[0], nx = b.st[1];
        if (nloc == 0u) { xcd_barrier_complete(bar, b.x, nloc, nx); b.st[0] = nloc; b.st[1] = nx; }
        const unsigned old = xb_add(&bar[XB_XSUB(b.x)], 1u);
        const unsigned gen = old / nloc;
        if (old + 1u == (gen + 1u) * nloc) {
            __builtin_amdgcn_fence(__ATOMIC_RELEASE, "agent");
            asm volatile("s_waitcnt vmcnt(0)" ::: "memory");
            const unsigned og = xb_add(&bar[XB_TOP], 1u);
            const unsigned tg = og / nx;
            if (og + 1u == (tg + 1u) * nx) xb_add(&bar[XB_TOPGEN], 1u);
            else XB_SPIN(xb_ld(&bar[XB_TOPGEN]) == tg, bar);
            __builtin_amdgcn_fence(__ATOMIC_ACQUIRE, "agent");
            xb_add(&bar[XB_XGEN(b.x)], 1u);
            asm volatile("s_waitcnt vmcnt(0)" ::: "memory");
        } else {
            XB_SPIN(xb_ld(&bar[XB_XGEN(b.x)]) == gen, bar);
            __builtin_amdgcn_fence(__ATOMIC_ACQUIRE, "agent");
            asm volatile("s_waitcnt vmcnt(0)" ::: "memory");
        }
    }
    __syncthreads();
}

constexpr int NWAVES = 8;
#ifndef P1_INTERLEAVE
#define P1_INTERLEAVE 1
#endif
#ifndef P1_SHARE
#define P1_SHARE 67
#endif
#ifndef MOE_FP8
#define MOE_FP8 1
#endif
constexpr float W8_SCALE = 64.f;
#ifndef PROBE_LINEAR
#define PROBE_LINEAR 0
#endif
#ifndef C3_FLASH
#define C3_FLASH 1
#endif
#ifndef PROBE_DUP_VALU
#define PROBE_DUP_VALU 0
#endif
#ifndef MOE_CONV_IN_P1
#define MOE_CONV_IN_P1 0
#endif
#ifndef REP_MASK
#define REP_MASK 0
#endif
#define RPF(k) ((((REP_MASK) >> (k)) & 1) ? 2 : 1)
constexpr int T = 16384, D = 2048, NPROJ = 8192, NPROJ_SRC = 8224, DMIX = 3072, NCONV = 3072;
constexpr int NEXP = 64, DEXP = 1024;
constexpr float EPS = 1e-6f;
constexpr size_t MiB = 1u << 20;
constexpr size_t WS_CTL = 0, CTL_ZERO_BYTES = 1 * MiB;
constexpr size_t WS_DT = 2 * MiB;
constexpr size_t WS_EID = 4 * MiB;
constexpr size_t WS_GATE = WS_EID + 256 * 1024;
constexpr size_t WS_POS = WS_GATE + 256 * 1024;
constexpr size_t WS_DEST = WS_POS + 256 * 1024;
constexpr size_t WS_TILE = WS_DEST + 256 * 1024;
constexpr size_t WS_HIST = WS_TILE + 4096;
constexpr size_t WS_RSTD = WS_HIST + 65536;
constexpr size_t WS_WR = 6 * MiB;
constexpr size_t WS_W1T = 8 * MiB;
constexpr size_t WS_WOT = 42 * MiB;
constexpr size_t WS_WGU = 54 * MiB;
constexpr size_t WS_WD = 566 * MiB;
constexpr size_t WS_HN = 822 * MiB;
constexpr size_t WS_PROJ = 886 * MiB;
constexpr size_t WS_XBC = 1142 * MiB;
constexpr size_t WS_XBT = 1238 * MiB;
constexpr size_t WS_PREV = 1318 * MiB;
constexpr size_t WS_CS = 1350 * MiB;
constexpr size_t WS_DECAY = 1352 * MiB;
constexpr size_t WS_MIX = 1366 * MiB;
constexpr size_t WS_STATES = 1462 * MiB;
constexpr size_t WS_OP = 1526 * MiB;
constexpr size_t WS_ML = 1622 * MiB;
constexpr size_t WS_ROWRS = 7 * MiB;
constexpr size_t WS_WQ8 = 1628 * MiB;
constexpr size_t WS_HN8 = 1634 * MiB;
constexpr size_t WS_END = 1666 * MiB;
constexpr size_t WS_XG = 886 * MiB;
constexpr size_t WS_HID = 1078 * MiB;
constexpr size_t WS_Y = 1174 * MiB;
constexpr int CW_TMO = 0, CW_CODE = 1, CW_CNT = 64, CW_BAR = 4096;
constexpr int RING_OFF = 0, RING_BYTES = 131072;
constexpr int LDSCTL_OFF = RING_BYTES, MISC_OFF = LDSCTL_OFF + 320;
constexpr int TAB_OFF = RING_BYTES + 1024;
constexpr int SSP_OFF = RING_BYTES + 2048;
constexpr int CSL_OFF = SSP_OFF + 8192;
constexpr int LDS_BYTES = 163840;

struct Args { const void* in[21]; float* out; unsigned char* ws; int ph_lo, ph_hi; };
struct Frame { LAS unsigned char* lds; volatile LAS unsigned* MISC; gu32* ctl; int tid, lane, wave, vcu, G, gw, NGW; };

__device__ __forceinline__ float bflo(unsigned w) { return __uint_as_float(w << 16); }
__device__ __forceinline__ float bfhi(unsigned w) { return __uint_as_float(w & 0xffff0000u); }
__device__ __forceinline__ float bf2f(unsigned short b) { return __uint_as_float((unsigned)b << 16); }
typedef float f32x2_t __attribute__((ext_vector_type(2))); typedef __bf16 bf16x2_t __attribute__((ext_vector_type(2)));
__device__ __forceinline__ float clamp8(float x) { return __builtin_amdgcn_fmed3f(x, -448.f, 448.f); }
__device__ __forceinline__ unsigned fp8x4(float a, float b, float c, float d) { int w = 0; w = __builtin_amdgcn_cvt_pk_fp8_f32(clamp8(a), clamp8(b), w, false); w = __builtin_amdgcn_cvt_pk_fp8_f32(clamp8(c), clamp8(d), w, true); return (unsigned)w; }
__device__ __forceinline__ unsigned cvtpk(float lo, float hi) { f32x2_t v = {lo, hi}; bf16x2_t b = __builtin_convertvector(v, bf16x2_t); return __builtin_bit_cast(unsigned, b); }
__device__ __forceinline__ float wave_sum(float v) {
#pragma unroll
    for (int o = 1; o < 64; o <<= 1) v += __shfl_xor(v, o);
    return v;
}
__device__ __forceinline__ float wave_max(float v) {
#pragma unroll
    for (int o = 1; o < 64; o <<= 1) v = fmaxf(v, __shfl_xor(v, o));
    return v;
}
template <int CTRL> __device__ __forceinline__ float dppf(float x) { return __builtin_bit_cast(float, __builtin_amdgcn_mov_dpp(__builtin_bit_cast(int, x), CTRL, 0xf, 0xf, true)); }
__device__ __forceinline__ float row16_sum(float v) {
    v += dppf<0xB1>(v); v += dppf<0x4E>(v); v += dppf<0x141>(v); v += dppf<0x140>(v); return v;
}
__device__ __forceinline__ float silu(float g) { return g * __builtin_amdgcn_rcpf(1.0f + __expf(-g)); }

__device__ __forceinline__ void tr_item(const float* W, int N, int k0, int n0, bf16* WT, int Kd, int drow0, LAS float* scr, int lane) {
#pragma unroll 8
    for (int i = 0; i < 32; ++i) { const int kk = 2 * i + (lane >> 5); scr[kk * 33 + (lane & 31)] = W[(size_t)(k0 + kk) * N + n0 + (lane & 31)]; }
    LDS_WAIT(); asm volatile("" ::: "memory");
    const int c = lane & 7;
#pragma unroll
    for (int j = 0; j < 4; ++j) { const int n = (lane >> 3) + 8 * j; const LAS float* s = scr + (8 * c) * 33 + n;
        v4u o; o.x = pk2(s[0 * 33], s[1 * 33]); o.y = pk2(s[2 * 33], s[3 * 33]); o.z = pk2(s[4 * 33], s[5 * 33]); o.w = pk2(s[6 * 33], s[7 * 33]);
        *(GAS v4u*)(WT + (size_t)(drow0 + n) * Kd + k0 + 8 * c) = o; }
    LDS_WAIT(); asm volatile("" ::: "memory");
}
__device__ __forceinline__ void rms_row_to_bf16(const float* xrow, const float* w, bf16* orow, int lane, unsigned char* o8row = nullptr) {
    const GAS f32x4* xr = (const GAS f32x4*)xrow + lane; const GAS f32x4* wr = (const GAS f32x4*)w + lane;
    f32x4 v[8]; float s = 0.f;
#pragma unroll
    for (int j = 0; j < 8; ++j) { v[j] = xr[64 * j]; s += (v[j].x * v[j].x + v[j].y * v[j].y) + (v[j].z * v[j].z + v[j].w * v[j].w); }
    const float rstd = 1.0f / sqrtf(wave_sum(s) * (1.0f / D) + EPS);
    GAS unsigned long long* o8 = (GAS unsigned long long*)orow + lane;
#pragma unroll
    for (int j = 0; j < 8; ++j) { const f32x4 ww = wr[64 * j]; const f32x4 o = v[j] * rstd * ww;
        o8[64 * j] = (unsigned long long)pk2(o.x, o.y) | ((unsigned long long)pk2(o.z, o.w) << 32);
        if (o8row) *(unsigned*)(o8row + 4 * lane + 256 * j) = fp8x4(o.x, o.y, o.z, o.w); }
}
__device__ __forceinline__ void cv_load(f32x4 (&v)[16], const float* W, int N, int k0, int n0, int lane) {
    const int q = lane >> 4, c = lane & 15;
    const float* src = W + (size_t)(k0 + 8 * q) * N + n0 + 4 * c;
#pragma unroll
    for (int i = 0; i < 8; ++i) { v[i] = *(const f32x4*)(src + (size_t)i * N); v[8 + i] = *(const f32x4*)(src + (size_t)(32 + i) * N); }
}
__device__ __forceinline__ void cv_store(const f32x4 (&v)[16], int k0, bf16* WT, int Kd, int drow0, int lane) {
    const int q = lane >> 4, c = lane & 15;
    bf16* dst = WT + (size_t)(drow0 + 4 * c) * Kd + k0 + 8 * q;
#pragma unroll
    for (int j = 0; j < 4; ++j) {
        v4u o0, o1;
        o0.x = pk2(v[0][j], v[1][j]); o0.y = pk2(v[2][j], v[3][j]); o0.z = pk2(v[4][j], v[5][j]); o0.w = pk2(v[6][j], v[7][j]);
        o1.x = pk2(v[8][j], v[9][j]); o1.y = pk2(v[10][j], v[11][j]); o1.z = pk2(v[12][j], v[13][j]); o1.w = pk2(v[14][j], v[15][j]);
        *(v4u*)(dst + (size_t)j * Kd) = o0; *(v4u*)(dst + (size_t)j * Kd + 32) = o1; }
}
__device__ __forceinline__ void cv_item(const float* W, int N, int k0, int n0, bf16* WT, int Kd, int drow0, int lane) { f32x4 v[16]; cv_load(v, W, N, k0, n0, lane); cv_store(v, k0, WT, Kd, drow0, lane); }
struct MoeCvItem { const float* W; bf16* WT; int N, k0, n0, Kd, drow0; };
__device__ __forceinline__ MoeCvItem moe_cv_decode(const Args& a, int it) {
    constexpr int I_G = (D / 64) * (DEXP / 64), I_D = (DEXP / 64) * (D / 64), I_E = 2 * I_G + I_D;
    const int e = it / I_E; int rr = it % I_E; MoeCvItem m;
    if (rr < 2 * I_G) { const int up = rr >= I_G; rr -= up * I_G; const int kb = rr / (DEXP / 64), nb = rr % (DEXP / 64), n0 = nb * 64;
        m.W = (const float*)(up ? a.in[19] : a.in[18]) + (size_t)e * D * DEXP; m.N = DEXP; m.k0 = kb * 64; m.n0 = n0; m.WT = (bf16*)(a.ws + WS_WGU) + (size_t)e * 2048 * D; m.Kd = D; m.drow0 = (n0 >> 7) * 256 + (n0 & 127) + up * 128; }
    else { rr -= 2 * I_G; const int kb = rr / (D / 64), nb = rr % (D / 64);
        m.W = (const float*)a.in[20] + (size_t)e * DEXP * D; m.N = D; m.k0 = kb * 64; m.n0 = nb * 64; m.WT = (bf16*)(a.ws + WS_WD) + (size_t)e * D * DEXP; m.Kd = DEXP; m.drow0 = nb * 64; }
    return m;
}
__device__ __forceinline__ void moe_weight_items(const Args& a, int wi, int nw, int lane) {
    constexpr int NIT = NEXP * 3 * 512;
    int cur = wi; if (cur >= NIT) return;
    f32x4 va[16], vb[16];
    MoeCvItem mc = moe_cv_decode(a, cur); cv_load(va, mc.W, mc.N, mc.k0, mc.n0, lane);
    for (;;) {
        int nxt = cur + nw; MoeCvItem mn = mc;
        if (nxt < NIT) { mn = moe_cv_decode(a, nxt); cv_load(vb, mn.W, mn.N, mn.k0, mn.n0, lane); }
        cv_store(va, mc.k0, mc.WT, mc.Kd, mc.drow0, lane);
        if (nxt >= NIT) break;
        cur = nxt; mc = mn; nxt = cur + nw;
        if (nxt < NIT) { mn = moe_cv_decode(a, nxt); cv_load(va, mn.W, mn.N, mn.k0, mn.n0, lane); }
        cv_store(vb, mc.k0, mc.WT, mc.Kd, mc.drow0, lane);
        if (nxt >= NIT) break;
        cur = nxt; mc = mn;
    }
}
#if MOE_FP8
struct MoeTile { const float* W; unsigned char* WT; int N, k0, n0, Kd, up, glu, d0; };
constexpr int NT_QKV = 8 * 12;
__device__ __forceinline__ MoeTile moe_tile_decode(const Args& a, int it) {
    MoeTile m;
    if (it < NT_QKV) { m.W = (const float*)a.in[3]; m.N = NPROJ_SRC; m.k0 = (it / 12) * 256; m.n0 = 5152 + (it % 12) * 256; m.WT = (unsigned char*)(a.ws + WS_WQ8); m.Kd = D; m.up = 0; m.glu = 0; m.d0 = (it % 12) * 256; return m; }
    it -= NT_QKV;
    const int e = it / 96; int rr = it % 96;
    if (rr < 64) { const int up = rr >= 32; rr -= up * 32; m.W = (const float*)(up ? a.in[19] : a.in[18]) + (size_t)e * D * DEXP; m.N = DEXP; m.k0 = (rr >> 2) * 256; m.n0 = (rr & 3) * 256;
        m.WT = (unsigned char*)(a.ws + WS_WGU) + (size_t)e * 2048 * D; m.Kd = D; m.up = up; m.glu = 1; m.d0 = (m.n0 >> 7) * 256 + up * 128; }
    else { rr -= 64; m.W = (const float*)a.in[20] + (size_t)e * DEXP * D; m.N = D; m.k0 = (rr >> 3) * 256; m.n0 = (rr & 7) * 256; m.WT = (unsigned char*)(a.ws + WS_WD) + (size_t)e * D * DEXP; m.Kd = DEXP; m.up = 0; m.glu = 0; m.d0 = m.n0; }
    return m;
}
__device__ __forceinline__ void moe_tile_load(f32x4 (&v)[16], const MoeTile& m, int half, int wave, int lane) {
    const float* src = m.W + (size_t)(m.k0 + 128 * half + 16 * wave) * m.N + m.n0 + 4 * lane;
#pragma unroll
    for (int i = 0; i < 16; ++i) v[i] = *(const f32x4*)(src + (size_t)i * m.N);
}
__device__ __forceinline__ void moe_tile_park(const f32x4 (&v)[16], LAS unsigned char* tl, int half, int wave, int lane) {
#pragma unroll
    for (int j = 0; j < 4; ++j) { v4u o;
        o.x = fp8x4(v[0][j] * W8_SCALE, v[1][j] * W8_SCALE, v[2][j] * W8_SCALE, v[3][j] * W8_SCALE); o.y = fp8x4(v[4][j] * W8_SCALE, v[5][j] * W8_SCALE, v[6][j] * W8_SCALE, v[7][j] * W8_SCALE);
        o.z = fp8x4(v[8][j] * W8_SCALE, v[9][j] * W8_SCALE, v[10][j] * W8_SCALE, v[11][j] * W8_SCALE); o.w = fp8x4(v[12][j] * W8_SCALE, v[13][j] * W8_SCALE, v[14][j] * W8_SCALE, v[15][j] * W8_SCALE);
        *(LAS v4u*)(tl + (4 * lane + j) * 256 + (((8 * half + wave) ^ ((lane + 4 * j) & 15)) << 4)) = o; }
}
constexpr int NT_ALL = NT_QKV + NEXP * 96;
__device__ __forceinline__ void moe_weight_tiles(const Args& a, Frame& F, int first, const int NT) {
    int cur = first; if (cur >= NT) return;
    int lane_ = F.lane, tid_ = F.tid; asm volatile("" : "+v"(lane_), "+v"(tid_));
#define MOE_TILE_WRITEOUT _Pragma("unroll") \
        for (int i = 0; i < 8; ++i) { \
            const int P = tid_ + 512 * i, q = P >> 10, p = P & 1023, gq = q >> 1, ktl = q & 1;   \
            const int st = p >> 6, sb = (p & 63) * 16, swz = sb ^ (((sb >> 9) & 1) << 5), Rimg = (st >> 1) * 16 + (swz >> 6), kbyte = (st & 1) * 64 + (swz & 63); \
            const int r128 = (Rimg & ~31) + pg8::perm32(Rimg & 31), row = gq * 128 + r128, ch = 8 * ktl + (kbyte >> 4); \
            const int drow = mc.d0 + gq * (mc.glu ? 256 : 128); \
            *(v4u*)(mc.WT + (size_t)drow * mc.Kd + (size_t)((mc.k0 >> 7) + ktl) * 16384 + p * 16) = *(const LAS v4u*)(tl + row * 256 + ((ch ^ (((row >> 2) + 4 * (row & 3)) & 15)) << 4)); }
    f32x4 va[16], vb[16];
    MoeTile mc = moe_tile_decode(a, cur); moe_tile_load(va, mc, 0, F.wave, lane_); moe_tile_load(vb, mc, 1, F.wave, lane_);
    int buf = 0;
    for (;;) {
        LAS unsigned char* tl = F.lds + RING_OFF + buf * 65536;
        const int nxt = cur + F.G; MoeTile mn = mc; const bool has = nxt < NT;
        if (has) mn = moe_tile_decode(a, nxt);
        moe_tile_park(va, tl, 0, F.wave, lane_);
        if (has) moe_tile_load(va, mn, 0, F.wave, lane_);
        moe_tile_park(vb, tl, 1, F.wave, lane_);
        if (has) moe_tile_load(vb, mn, 1, F.wave, lane_);
        __syncthreads();
        MOE_TILE_WRITEOUT
        if (!has) break;
        cur = nxt; mc = mn; buf ^= 1;
    }
#undef MOE_TILE_WRITEOUT
    __syncthreads();
}
#else
struct MoeTile { const float* W; bf16* WT; int N, k0, n0, Kd, up, glu; };
__device__ __forceinline__ MoeTile moe_tile_decode(const Args& a, int it) {
    const int e = it / 192; int rr = it % 192; MoeTile m;
    if (rr < 128) { const int up = rr >= 64; rr -= up * 64; m.W = (const float*)(up ? a.in[19] : a.in[18]) + (size_t)e * D * DEXP; m.N = DEXP; m.k0 = (rr >> 2) * 128; m.n0 = (rr & 3) * 256;
        m.WT = (bf16*)(a.ws + WS_WGU) + (size_t)e * 2048 * D; m.Kd = D; m.up = up; m.glu = 1; }
    else { rr -= 128; m.W = (const float*)a.in[20] + (size_t)e * DEXP * D; m.N = D; m.k0 = (rr >> 3) * 128; m.n0 = (rr & 7) * 256; m.WT = (bf16*)(a.ws + WS_WD) + (size_t)e * D * DEXP; m.Kd = DEXP; m.up = 0; m.glu = 0; }
    return m;
}
__device__ __forceinline__ void moe_tile_load(f32x4 (&v)[16], const MoeTile& m, int wave, int lane) {
    const float* src = m.W + (size_t)(m.k0 + 16 * wave) * m.N + m.n0 + 4 * lane;
#pragma unroll
    for (int i = 0; i < 16; ++i) v[i] = *(const f32x4*)(src + (size_t)i * m.N);
}
__device__ __forceinline__ void moe_weight_tiles(const Args& a, Frame& F) {
    constexpr int NT = NEXP * 192;
    int cur = (int)blockIdx.x; if (cur >= NT) return;
    f32x4 va[16], vb[16];
    MoeTile mc = moe_tile_decode(a, cur); moe_tile_load(va, mc, F.wave, F.lane);
    int buf = 0;
#define MOE_TILE_STEP(VCUR, VNXT) { \
        const int nxt = cur + F.G; MoeTile mn = mc; \
        if (nxt < NT) { mn = moe_tile_decode(a, nxt); moe_tile_load(VNXT, mn, F.wave, F.lane); } \
        LAS unsigned char* tl = F.lds + RING_OFF + buf * 65536; \
        _Pragma("unroll") for (int j = 0; j < 4; ++j) { v4u o0, o1; \
            o0.x = pk2(VCUR[0][j], VCUR[1][j]); o0.y = pk2(VCUR[2][j], VCUR[3][j]); o0.z = pk2(VCUR[4][j], VCUR[5][j]); o0.w = pk2(VCUR[6][j], VCUR[7][j]); \
            o1.x = pk2(VCUR[8][j], VCUR[9][j]); o1.y = pk2(VCUR[10][j], VCUR[11][j]); o1.z = pk2(VCUR[12][j], VCUR[13][j]); o1.w = pk2(VCUR[14][j], VCUR[15][j]); \
            LAS unsigned char* p = tl + (4 * F.lane + j) * 256; *(LAS v4u*)(p + (((2 * F.wave) ^ (F.lane & 15)) << 4)) = o0; *(LAS v4u*)(p + (((2 * F.wave + 1) ^ (F.lane & 15)) << 4)) = o1; } \
        __syncthreads(); \
        _Pragma("unroll") for (int i = 0; i < 8; ++i) { const int piece = F.tid + 512 * i, row = piece >> 4, ch = piece & 15, n = mc.n0 + row; \
            const int drow = mc.glu ? ((n >> 7) * 256 + (n & 127) + mc.up * 128) : n; \
            *(v4u*)(mc.WT + (size_t)drow * mc.Kd + mc.k0 + 8 * ch) = *(const LAS v4u*)(tl + row * 256 + ((ch ^ ((row >> 2) & 15)) << 4)); } \
        if (nxt >= NT) break; \
        cur = nxt; mc = mn; buf ^= 1; }
    for (;;) { MOE_TILE_STEP(va, vb) MOE_TILE_STEP(vb, va) }
#undef MOE_TILE_STEP
    __syncthreads();
}
#endif
__device__ __forceinline__ void p0_prologue(const Args& a, Frame& F) {
    LAS float* scr = (LAS float*)(F.lds + RING_OFF + F.wave * 16384);
    const float* w_in = (const float*)a.in[3]; const float* w_out = (const float*)a.in[12];
    bf16* W1T = (bf16*)(a.ws + WS_W1T); bf16* WOT = (bf16*)(a.ws + WS_WOT);
    constexpr int NB_IN = NPROJ_SRC / 32;
    constexpr int I_IN = (D / 64) * NB_IN, I_OUT = (DMIX / 64) * (D / 64);
    for (int it = F.gw; it < I_IN + I_OUT; it += F.NGW) {
        if (it < I_IN) { const int kb = it / NB_IN, nb = it % NB_IN, n0 = nb * 32;
            if (MOE_FP8 && n0 >= 5152) continue;
            const int drow = n0 < 5120 ? n0 : (n0 < 5152 ? 8192 + (n0 - 5120) : n0 - 32);
            tr_item(w_in, NPROJ_SRC, kb * 64, n0, W1T, D, drow, scr, F.lane); }
        else { const int r = it - I_IN, kb = r / (D / 64), nb = r % (D / 64); cv_item(w_out, D, kb * 64, nb * 64, WOT, DMIX, nb * 64, F.lane); }
    }
    { const float* Wgr = (const float*)a.in[14]; const float* Wer = (const float*)a.in[16]; bf16* WRH = (bf16*)(a.ws + WS_WR); bf16* WRL = WRH + 80 * D;
      for (int idx = F.gw * 64 + F.lane; idx < 80 * D; idx += F.NGW * 64) { const int c = idx / D, k = idx % D; float v = 0.f;
          if (c < 8) v = Wgr[(size_t)k * 8 + c]; else if (c < 72) { const int g = (c - 8) >> 3, e = (c - 8) & 7; v = Wer[((size_t)g * D + k) * 8 + e]; }
          const unsigned hi = f2bf(v); const float rem = v - __uint_as_float(hi << 16);
          const int di = ((((c >> 4) * 8 + (k >> 8)) * 8 + ((k >> 5) & 7)) * 64 + ((c & 15) + 16 * ((k >> 3) & 3))) * 8 + (k & 7);
          WRH[di] = (bf16)hi; WRL[di] = (bf16)f2bf(rem); } }
    const float* x = (const float*)a.in[0]; const float* n1w = (const float*)a.in[2]; bf16* HN = (bf16*)(a.ws + WS_HN);
    {
        const int lane = F.lane; const GAS f32x4* wr = (const GAS f32x4*)n1w + lane;
        int m = F.gw; f32x4 v[8];
        if (m < T) { const GAS f32x4* xr = (const GAS f32x4*)(x + (size_t)m * D) + lane;
#pragma unroll
            for (int j = 0; j < 8; ++j) v[j] = xr[64 * j]; }
#pragma unroll 1
        while (m < T) {
            const int mn = m + F.NGW; f32x4 vn[8];
            { const GAS f32x4* xr = (const GAS f32x4*)(x + (size_t)(mn < T ? mn : m) * D) + lane;
#pragma unroll
              for (int j = 0; j < 8; ++j) vn[j] = xr[64 * j]; }
            float s = 0.f;
#pragma unroll
            for (int j = 0; j < 8; ++j) s += (v[j].x * v[j].x + v[j].y * v[j].y) + (v[j].z * v[j].z + v[j].w * v[j].w);
            const float rstd = 1.0f / sqrtf(wave_sum(s) * (1.0f / D) + EPS);
            GAS unsigned long long* o8 = (GAS unsigned long long*)(HN + (size_t)m * D) + lane; unsigned char* o8row = (unsigned char*)(a.ws + WS_HN8) + (size_t)m * D;
#pragma unroll
            for (int j = 0; j < 8; ++j) { const f32x4 ww = wr[64 * j]; const f32x4 o = v[j] * rstd * ww;
                o8[64 * j] = (unsigned long long)pk2(o.x, o.y) | ((unsigned long long)pk2(o.z, o.w) << 32);
                if (MOE_FP8) *(unsigned*)(o8row + 4 * lane + 256 * j) = fp8x4(o.x, o.y, o.z, o.w); }
#pragma unroll
            for (int j = 0; j < 8; ++j) v[j] = vn[j];
            m = mn; }
    }
    __syncthreads();
#if MOE_FP8
    moe_weight_tiles(a, F, (int)blockIdx.x, P1_INTERLEAVE ? NT_QKV : NT_ALL);
#else
    moe_weight_tiles(a, F);
#endif
}

__device__ __forceinline__ void p2_postproj(const Args& a, Frame& F) {
    bf16* PROJ = (bf16*)(a.ws + WS_PROJ); const bf16* HN = (const bf16*)(a.ws + WS_HN); const bf16* WDTT = (const bf16*)(a.ws + WS_W1T) + (size_t)8192 * D;
    float* DT = (float*)(a.ws + WS_DT); bf16* XBC = (bf16*)(a.ws + WS_XBC);
    const int lane = F.lane;
    { const float* dt_bias = (const float*)a.in[6];
      for (int itt = F.gw; itt < (T / 8) * RPF(23); itt += F.NGW) { const int it = (itt & (T / 8 - 1)) >> 1, ct = itt & 1;
        const int t0 = it * 16; f32x4 acc0 = {0.f, 0.f, 0.f, 0.f}, acc1 = {0.f, 0.f, 0.f, 0.f};
        const bf16* ap = HN + (size_t)(t0 + (lane & 15)) * D + 8 * (lane >> 4);
        const bf16* bp0 = WDTT + (size_t)(ct * 16 + (lane & 15)) * D + 8 * (lane >> 4);
#pragma unroll 4
        for (int s = 0; s < D / 64; ++s) { const bf16x8 av0 = *(const bf16x8*)(ap + 64 * s), b0 = *(const bf16x8*)(bp0 + 64 * s), av1 = *(const bf16x8*)(ap + 64 * s + 32), b1 = *(const bf16x8*)(bp0 + 64 * s + 32);
            acc0 = __builtin_amdgcn_mfma_f32_16x16x32_bf16(av0, b0, acc0, 0, 0, 0); acc1 = __builtin_amdgcn_mfma_f32_16x16x32_bf16(av1, b1, acc1, 0, 0, 0); }
        const int hd0 = ct * 16 + (lane & 15); const float bi0 = dt_bias[hd0]; f32x4 d0;
#pragma unroll
        for (int r = 0; r < 4; ++r) { float v0 = acc0[r] + acc1[r] + bi0; v0 = v0 > 20.f ? v0 : log1pf(expf(v0)); d0[r] = v0; }
        *(f32x4*)(DT + (size_t)hd0 * T + t0 + (lane >> 4) * 4) = d0;
      } }
    { const float* cw = (const float*)a.in[4]; const float* cb = (const float*)a.in[5]; bf16* XBT = (bf16*)(a.ws + WS_XBT);
      for (int itt = F.gw; itt < (T / 64) * (NCONV / 128) * RPF(2); itt += F.NGW) { const int it = itt % ((T / 64) * (NCONV / 128));
        const int cbk = it / (T / 64), tb = it % (T / 64), c = cbk * 128 + 2 * lane, t0 = tb * 64;
        const float w00 = cw[c], w01 = cw[c + 1], w10 = cw[NCONV + c], w11 = cw[NCONV + c + 1], w20 = cw[2 * NCONV + c], w21 = cw[2 * NCONV + c + 1], w30 = cw[3 * NCONV + c], w31 = cw[3 * NCONV + c + 1];
        const float b0 = cb[c], b1 = cb[c + 1];
        const bf16* src = PROJ + 2048 + c;
        float r00 = 0.f, r01 = 0.f, r10 = 0.f, r11 = 0.f, r20 = 0.f, r21 = 0.f;
        if (t0 > 0) { const unsigned u0 = *(const unsigned*)(src + (size_t)(t0 - 3) * NPROJ), u1 = *(const unsigned*)(src + (size_t)(t0 - 2) * NPROJ), u2 = *(const unsigned*)(src + (size_t)(t0 - 1) * NPROJ);
            r00 = bflo(u0); r01 = bfhi(u0); r10 = bflo(u1); r11 = bfhi(u1); r20 = bflo(u2); r21 = bfhi(u2); }
        unsigned xt0[32], xt1[32];
#pragma unroll
        for (int tt = 0; tt < 32; ++tt) {
            const unsigned ua = *(const unsigned*)(src + (size_t)(t0 + 2 * tt) * NPROJ), ub = *(const unsigned*)(src + (size_t)(t0 + 2 * tt + 1) * NPROJ);
            const float a0 = bflo(ua), a1 = bfhi(ua), c0 = bflo(ub), c1 = bfhi(ub);
            const float ya0 = silu(b0 + w00 * r00 + w10 * r10 + w20 * r20 + w30 * a0), ya1 = silu(b1 + w01 * r01 + w11 * r11 + w21 * r21 + w31 * a1);
            const float yb0 = silu(b0 + w00 * r10 + w10 * r20 + w20 * a0 + w30 * c0), yb1 = silu(b1 + w01 * r11 + w11 * r21 + w21 * a1 + w31 * c1);
            *(unsigned*)(XBC + (size_t)(t0 + 2 * tt) * NCONV + c) = pk2(ya0, ya1); *(unsigned*)(XBC + (size_t)(t0 + 2 * tt + 1) * NCONV + c) = pk2(yb0, yb1);
            xt0[tt] = pk2(ya0, yb0); xt1[tt] = pk2(ya1, yb1);
            r00 = r20; r01 = r21; r10 = a0; r11 = a1; r20 = c0; r21 = c1; }
        if (cbk < 20) {
            LAS unsigned char* tt_ = F.lds + RING_OFF + F.wave * 16384;
#pragma unroll
            for (int k = 0; k < 8; ++k) { v4u u; u.x = xt0[4 * k]; u.y = xt0[4 * k + 1]; u.z = xt0[4 * k + 2]; u.w = xt0[4 * k + 3]; *(LAS v4u*)(tt_ + (2 * lane) * 128 + ((k ^ (lane & 7)) << 4)) = u;
                v4u w; w.x = xt1[4 * k]; w.y = xt1[4 * k + 1]; w.z = xt1[4 * k + 2]; w.w = xt1[4 * k + 3]; *(LAS v4u*)(tt_ + (2 * lane + 1) * 128 + ((k ^ (lane & 7)) << 4)) = w; }
            LDS_WAIT(); asm volatile("" ::: "memory");
#pragma unroll
            for (int i = 0; i < 16; ++i) { const int rb = i >> 2, ksl = i & 3, row = rb * 32 + (lane & 31), pc = 2 * ksl + (lane >> 5);
                const size_t fo = ((size_t)((cbk * 4 + rb) * 64 + (t0 >> 8)) * 16 + ((t0 & 255) >> 4) + ksl) * 1024 + lane * 16;
                *(v4u*)((unsigned char*)XBT + fo) = *(const LAS v4u*)(tt_ + row * 128 + ((pc ^ ((row >> 1) & 7)) << 4)); }
            LDS_WAIT(); asm volatile("" ::: "memory"); }
      } }
    { const int* positions = (const int*)a.in[1]; const float* qnw = (const float*)a.in[10]; const float* knw = (const float*)a.in[11];
      const int hv = lane >> 1, half = lane & 1; const float* nw = (hv < 16 ? qnw : knw) + half * 32;
      float nwv[32];
#pragma unroll
      for (int i = 0; i < 32; ++i) nwv[i] = nw[i];
      const float invf[8] = {1.0f, 0.19392274474868576f, 0.03760603093086393f, 0.007292664737217109f, 0.001414213562373095f, 0.0002742481756762073f, 5.318295896944988e-05f, 1.031338537721246e-05f};
      for (int t = F.gw; t < T; t += F.NGW) {
        v4u* p = (v4u*)(PROJ + (size_t)t * NPROJ + 5120 + lane * 32);
        float v[32]; float ss = 0.f;
#pragma unroll
        for (int j = 0; j < 4; ++j) { const v4u u = p[j];
            v[8 * j + 0] = bflo(u.x); v[8 * j + 1] = bfhi(u.x); v[8 * j + 2] = bflo(u.y); v[8 * j + 3] = bfhi(u.y); v[8 * j + 4] = bflo(u.z); v[8 * j + 5] = bfhi(u.z); v[8 * j + 6] = bflo(u.w); v[8 * j + 7] = bfhi(u.w); }
#pragma unroll
        for (int i = 0; i < 32; ++i) ss += v[i] * v[i];
        ss += dppf<0xB1>(ss);
        const float rstd = 1.0f / sqrtf(ss * (1.0f / 64.0f) + EPS);
#pragma unroll
        for (int i = 0; i < 32; ++i) v[i] = v[i] * rstd * nwv[i];
        if (half == 0) { const float pos = (float)positions[t];
#pragma unroll
            for (int i = 0; i < 8; ++i) { float sn, cs;
                { const float ch[8] = {0.15915493667125702f, 0.030863763764500618f, 0.005985185503959656f, 0.0011606636689975858f, 0.0002250790857942775f, 4.3647953134495765e-05f, 8.464330676360987e-06f, 1.6414262518082978e-06f};
                  const float cl[8] = {6.4206382432985265e-09f, -3.597993847304082e-10f, 2.0875405570830452e-10f, -2.775752544481591e-11f, -6.755001072389355e-12f, -3.4169287408195026e-13f, 1.3188041424975344e-13f, 1.0986736456860494e-14f};
                  const float p = pos * ch[i], e = __builtin_fmaf(pos, ch[i], -p); const float rev = __builtin_amdgcn_fractf(p) + (e + pos * cl[i]);
                  sn = __builtin_amdgcn_sinf(rev); cs = __builtin_amdgcn_cosf(rev); }
                const float x1 = v[i], x2 = v[8 + i]; v[i] = x1 * cs - x2 * sn; v[8 + i] = x2 * cs + x1 * sn; } }
        const float sc = hv < 16 ? 0.125f * 1.4426950408889634f : 1.0f;
#pragma unroll
        for (int j = 0; j < 4; ++j) { v4u u; u.x = pk2(v[8 * j + 0] * sc, v[8 * j + 1] * sc); u.y = pk2(v[8 * j + 2] * sc, v[8 * j + 3] * sc); u.z = pk2(v[8 * j + 4] * sc, v[8 * j + 5] * sc); u.w = pk2(v[8 * j + 6] * sc, v[8 * j + 7] * sc); p[j] = u; }
      } }
}

typedef float f32x16 __attribute__((ext_vector_type(16)));
__device__ __forceinline__ bf16x8 scale8(const bf16x8 a, const f32x4 w0, const f32x4 w1) {
    const v4u u = __builtin_bit_cast(v4u, a); v4u o;
    o.x = cvtpk(bflo(u.x) * w0.x, bfhi(u.x) * w0.y); o.y = cvtpk(bflo(u.y) * w0.z, bfhi(u.y) * w0.w);
    o.z = cvtpk(bflo(u.z) * w1.x, bfhi(u.z) * w1.y); o.w = cvtpk(bflo(u.w) * w1.z, bfhi(u.w) * w1.w);
    return __builtin_bit_cast(bf16x8, o);
}
__device__ __forceinline__ void ssd_c1(const Args& a, Frame& F) {
    const bf16* XBT = (const bf16*)(a.ws + WS_XBT); const float* DT = (const float*)(a.ws + WS_DT); const float* A_log = (const float*)a.in[7];
    float* CS = (float*)(a.ws + WS_CS); float* DECAY = (float*)(a.ws + WS_DECAY); float* STATES = (float*)(a.ws + WS_STATES);
    LAS float* wl = (LAS float*)(F.lds + RING_OFF + F.wave * 2048);
    const int lane = F.lane, r = lane & 31, hh = lane >> 5;
    for (int uu = (int)blockIdx.x; uu < 256 * RPF(13); uu += F.G) { const int u = uu & 255;
        const int c = u >> 2, g = u & 3, h = g * 8 + F.wave, t0 = c * 256;
        const float A = -expf(A_log[h]);
        float d4[4], c4[4];
        { const f32x4 dq = *(const f32x4*)(DT + (size_t)h * T + t0 + 4 * lane); d4[0] = dq.x; d4[1] = dq.y; d4[2] = dq.z; d4[3] = dq.w; }
        c4[0] = d4[0] * A; c4[1] = c4[0] + d4[1] * A; c4[2] = c4[1] + d4[2] * A; c4[3] = c4[2] + d4[3] * A;
        float inc = c4[3];
#pragma unroll
        for (int o = 1; o < 64; o <<= 1) { const float n = __shfl_up(inc, o); if (lane >= o) inc += n; }
        const float excl = inc - c4[3];
        const float total = __shfl(inc, 63);
        f32x4 csv; csv.x = excl + c4[0]; csv.y = excl + c4[1]; csv.z = excl + c4[2]; csv.w = excl + c4[3];
        *(f32x4*)(CS + (size_t)h * T + t0 + 4 * lane) = csv;
        if (lane == 0) DECAY[c * 32 + h] = __expf(total);
        f32x4 wv; wv.x = d4[0] * __expf(total - csv.x); wv.y = d4[1] * __expf(total - csv.y); wv.z = d4[2] * __expf(total - csv.z); wv.w = d4[3] * __expf(total - csv.w);
        *(LAS f32x4*)(wl + 4 * lane) = wv;
        LDS_WAIT(); asm volatile("" ::: "memory");
        f32x16 acc[2][4];
#pragma unroll
        for (int pt = 0; pt < 2; ++pt)
#pragma unroll
            for (int nt = 0; nt < 4; ++nt)
#pragma unroll
                for (int i = 0; i < 16; ++i) acc[pt][nt][i] = 0.f;
        const unsigned char* xa = (const unsigned char*)XBT + ((size_t)((h * 2) * 64 + c) * 16) * 1024 + lane * 16; const unsigned char* xb = (const unsigned char*)XBT + ((size_t)((64 + g * 4) * 64 + c) * 16) * 1024 + lane * 16;
#pragma unroll 2
        for (int ks = 0; ks < 16; ++ks) {
            const f32x4 w0 = *(const LAS f32x4*)(wl + 16 * ks + 8 * hh), w1 = *(const LAS f32x4*)(wl + 16 * ks + 8 * hh + 4);
            bf16x8 af[2], bfr[4];
#pragma unroll
            for (int pt = 0; pt < 2; ++pt) af[pt] = scale8(*(const bf16x8*)(xa + (size_t)pt * (64 * 16 * 1024) + ks * 1024), w0, w1);
#pragma unroll
            for (int nt = 0; nt < 4; ++nt) bfr[nt] = *(const bf16x8*)(xb + (size_t)nt * (64 * 16 * 1024) + ks * 1024);
#pragma unroll
            for (int pt = 0; pt < 2; ++pt)
#pragma unroll
                for (int nt = 0; nt < 4; ++nt) acc[pt][nt] = __builtin_amdgcn_mfma_f32_32x32x16_bf16(af[pt], bfr[nt], acc[pt][nt], 0, 0, 0);
        }
        float* sp = STATES + (size_t)(c * 32 + h) * 8192;
#pragma unroll
        for (int pt = 0; pt < 2; ++pt)
#pragma unroll
            for (int nt = 0; nt < 4; ++nt)
#pragma unroll
                for (int i = 0; i < 16; ++i) sp[(size_t)(pt * 32 + (i & 3) + 8 * (i >> 2) + 4 * hh) * 128 + nt * 32 + r] = acc[pt][nt][i];
        LDS_WAIT(); asm volatile("" ::: "memory");
    }
}
__device__ __forceinline__ void ssd_c2(const Args& a, Frame& F) {
    const float* STATES = (const float*)(a.ws + WS_STATES); const float* DECAY = (const float*)(a.ws + WS_DECAY); bf16* PREV = (bf16*)(a.ws + WS_PREV);
    for (int idx = (int)blockIdx.x * (NWAVES * 64) + F.tid; idx < 32 * 64 * 128 / 2 * RPF(14); idx += F.G * NWAVES * 64) {
        const int e0 = (idx & (32 * 64 * 128 / 2 - 1)) * 2, h = e0 >> 13, rest = e0 & 8191;
        float s0 = 0.f, s1 = 0.f;
#pragma unroll 8
        for (int c = 0; c < 64; ++c) {
            const size_t o = (size_t)(c * 32 + h) * 8192 + rest;
            *(unsigned*)(PREV + o) = pk2(s0, s1);
            const float dec = DECAY[c * 32 + h]; const float2 st = *(const float2*)(STATES + o);
            s0 = s0 * dec + st.x; s1 = s1 * dec + st.y;
        }
    }
}
__device__ __forceinline__ v4u ldg16(const void* base, unsigned off) { return *(const v4u*)((const char*)base + off); }
__device__ __forceinline__ unsigned long long ldg8(const void* base, unsigned off) { return *(const unsigned long long*)((const char*)base + off); }
__device__ __forceinline__ void ssd_c3(const Args& a, Frame& F) {
    const unsigned char* ws = a.ws;
    const float* Dsk = (const float*)a.in[8]; const float* snw = (const float*)a.in[9];
    LAS unsigned char* CBL = F.lds + RING_OFF; LAS float* ssp = (LAS float*)(F.lds + SSP_OFF); LAS float* csl = (LAS float*)(F.lds + CSL_OFF + F.wave * 2048); LAS float* dtl = csl + 256;
    const int lane = F.lane, r = lane & 31, hh = lane >> 5, wave = F.wave;
    for (int uu = (int)blockIdx.x; uu < 256 * RPF(5); uu += F.G) { const int u = uu & 255;
        const int c = u >> 2, g = u & 3, t0 = c * 256;
        {
#pragma unroll 1
          for (int idx2 = wave; idx2 < 36 * RPF(20); idx2 += 8) { const int idx = idx2 >= 36 ? idx2 - 36 : idx2; int lt = 0; while ((lt + 1) * (lt + 2) / 2 <= idx) ++lt; const int st = idx - lt * (lt + 1) / 2;
            f32x16 acc;
#pragma unroll
            for (int i = 0; i < 16; ++i) acc[i] = 0.f;
            const unsigned bo = (unsigned)((t0 + st * 32 + r) * NCONV + 2048 + g * 128 + 8 * hh) * 2u, co = (unsigned)((t0 + lt * 32 + r) * NCONV + 2560 + g * 128 + 8 * hh) * 2u;
#pragma unroll
            for (int kn = 0; kn < 8; ++kn) acc = __builtin_amdgcn_mfma_f32_32x32x16_bf16(__builtin_bit_cast(bf16x8, ldg16(ws + WS_XBC, bo + 32 * kn)), __builtin_bit_cast(bf16x8, ldg16(ws + WS_XBC, co + 32 * kn)), acc, 0, 0, 0);
            const int row = lt * 32 + r;
#pragma unroll
            for (int i4 = 0; i4 < 4; ++i4) { const int chunk = st * 4 + i4;
                const unsigned long long w = (unsigned long long)cvtpk(acc[4 * i4], acc[4 * i4 + 1]) | ((unsigned long long)cvtpk(acc[4 * i4 + 2], acc[4 * i4 + 3]) << 32);
                *(LAS unsigned long long*)(CBL + row * 512 + ((chunk ^ (row & 15)) << 4) + 8 * hh) = w; } } }
        __syncthreads();
#pragma unroll 1
        for (int pass2 = 0; pass2 < 2 * RPF(21); ++pass2) { const int pass = pass2 & 1;
            const int e = pass * 4 + (wave >> 1), pt = wave & 1, h = g * 8 + e;
            { const unsigned o4 = (unsigned)(h * T + t0 + 4 * lane) * 4u;
              const f32x4 cv = *(const f32x4*)(ws + WS_CS + o4); const f32x4 dv = *(const f32x4*)(ws + WS_DT + o4);
              *(LAS f32x4*)(csl + 4 * lane) = cv; *(LAS f32x4*)(dtl + 4 * lane) = dv; }
            bf16x8 xa[16], pa[8];
            { const unsigned xo = (unsigned)((h * 64 + pt * 32 + r) * T + t0 + 8 * hh) * 2u;
#pragma unroll
              for (int ks = 0; ks < 16; ++ks) xa[ks] = __builtin_bit_cast(bf16x8, ldg16(ws + WS_XBT, xo + 32 * ks));
              const unsigned po = (unsigned)(((c * 32 + h) * 64 + pt * 32 + r) * 128 + 8 * hh) * 2u;
#pragma unroll
              for (int kn = 0; kn < 8; ++kn) pa[kn] = __builtin_bit_cast(bf16x8, ldg16(ws + WS_PREV, po + 32 * kn)); }
            LDS_WAIT(); asm volatile("" ::: "memory");
            v4u cf[8];
            { const unsigned coff0 = ((unsigned)(t0 + r) * NCONV + 2560 + g * 128 + 8 * hh) * 2u;
#pragma unroll
              for (int kn = 0; kn < 8; ++kn) cf[kn] = ldg16(ws + WS_XBC, coff0 + 32 * kn); }
#pragma unroll 1
            for (int lt = 0; lt < 8; ++lt) {
                int r15 = r & 15; asm volatile("" : "+v"(r15));
                const int lrow = lt * 32 + r, t = t0 + lrow; const float csv = csl[lrow];
                const unsigned pcol = (unsigned)(h * 64 + pt * 32 + 4 * hh);
                const unsigned xoff = ((unsigned)t * NCONV + pcol) * 2u, zoff = ((unsigned)t * NPROJ + pcol) * 2u, moff = ((unsigned)t * DMIX + pcol) * 2u;
                f32x16 ad, ao;
#pragma unroll
                for (int i = 0; i < 16; ++i) ao[i] = 0.f;
#pragma unroll
                for (int kn = 0; kn < 8; ++kn) ao = __builtin_amdgcn_mfma_f32_32x32x16_bf16(pa[kn], __builtin_bit_cast(bf16x8, cf[kn]), ao, 0, 0, 0);
                { const unsigned coff = ((unsigned)(t + (lt < 7 ? 32 : 0)) * NCONV + 2560 + g * 128 + 8 * hh) * 2u;
#pragma unroll
                  for (int kn = 0; kn < 8; ++kn) cf[kn] = ldg16(ws + WS_XBC, coff + 32 * kn); }
                const float el = __expf(csv);
#pragma unroll
                for (int i = 0; i < 16; ++i) ad[i] = el * ao[i];
#pragma unroll
                for (int ks = 0; ks < 16; ++ks) { if (ks < 2 * (lt + 1)) {
                    const int s0 = 16 * ks + 8 * hh;
                    const v4u cb = *(const LAS v4u*)(CBL + lrow * 512 + (((2 * ks + hh) ^ r15) << 4));
                    const f32x4 c0 = *(const LAS f32x4*)(csl + s0), c1 = *(const LAS f32x4*)(csl + s0 + 4), d0 = *(const LAS f32x4*)(dtl + s0), d1 = *(const LAS f32x4*)(dtl + s0 + 4);
                    float m[8];
                    m[0] = bflo(cb.x) * __expf(csv - c0.x) * d0.x; m[1] = bfhi(cb.x) * __expf(csv - c0.y) * d0.y; m[2] = bflo(cb.y) * __expf(csv - c0.z) * d0.z; m[3] = bfhi(cb.y) * __expf(csv - c0.w) * d0.w;
                    m[4] = bflo(cb.z) * __expf(csv - c1.x) * d1.x; m[5] = bfhi(cb.z) * __expf(csv - c1.y) * d1.y; m[6] = bflo(cb.w) * __expf(csv - c1.z) * d1.z; m[7] = bfhi(cb.w) * __expf(csv - c1.w) * d1.w;
                    if (ks >= 2 * lt) {
#pragma unroll
                        for (int j = 0; j < 8; ++j) m[j] = (s0 + j <= lrow) ? m[j] : 0.f; }
                    v4u bo; bo.x = cvtpk(m[0], m[1]); bo.y = cvtpk(m[2], m[3]); bo.z = cvtpk(m[4], m[5]); bo.w = cvtpk(m[6], m[7]);
                    ad = __builtin_amdgcn_mfma_f32_32x32x16_bf16(xa[ks], __builtin_bit_cast(bf16x8, bo), ad, 0, 0, 0); }
                    __builtin_amdgcn_sched_barrier(0); }
#pragma unroll
                for (int i4 = 0; i4 < 4; ++i4)
                    *(unsigned long long*)((unsigned char*)a.ws + WS_MIX + (moff + 16 * i4)) = (unsigned long long)pk2(ad[4 * i4], ad[4 * i4 + 1]) | ((unsigned long long)pk2(ad[4 * i4 + 2], ad[4 * i4 + 3]) << 32);
            }
            LDS_WAIT(); asm volatile("" ::: "memory");
        }
        __syncthreads();
        { const f32x4 w0 = *(const f32x4*)(snw + g * 512 + lane * 8), w1 = *(const f32x4*)(snw + g * 512 + lane * 8 + 4); const float dsk = Dsk[g * 8 + (lane >> 3)];
#pragma unroll 4
          for (int tk = 0; tk < 32; ++tk) { const unsigned tl = (unsigned)(t0 + wave * 32 + tk);
            v4u* mp = (v4u*)((unsigned char*)a.ws + WS_MIX + (tl * DMIX + g * 512 + lane * 8) * 2u); const v4u q = *mp;
            const v4u xv = ldg16(ws + WS_XBC, (tl * NCONV + g * 512 + lane * 8) * 2u), zv = ldg16(ws + WS_PROJ, (tl * NPROJ + g * 512 + lane * 8) * 2u);
            const float f0 = (bflo(q.x) + dsk * bflo(xv.x)) * silu(bflo(zv.x)), f1 = (bfhi(q.x) + dsk * bfhi(xv.x)) * silu(bfhi(zv.x)), f2 = (bflo(q.y) + dsk * bflo(xv.y)) * silu(bflo(zv.y)), f3 = (bfhi(q.y) + dsk * bfhi(xv.y)) * silu(bfhi(zv.y));
            const float f4 = (bflo(q.z) + dsk * bflo(xv.z)) * silu(bflo(zv.z)), f5 = (bfhi(q.z) + dsk * bfhi(xv.z)) * silu(bfhi(zv.z)), f6 = (bflo(q.w) + dsk * bflo(xv.w)) * silu(bflo(zv.w)), f7 = (bfhi(q.w) + dsk * bfhi(xv.w)) * silu(bfhi(zv.w));
            const float tot = wave_sum((f0 * f0 + f1 * f1) + (f2 * f2 + f3 * f3) + (f4 * f4 + f5 * f5) + (f6 * f6 + f7 * f7));
            const float rstd = __builtin_amdgcn_rsqf(tot * (1.0f / 512.0f) + EPS); v4u o;
            o.x = pk2(f0 * rstd * w0.x, f1 * rstd * w0.y); o.y = pk2(f2 * rstd * w0.z, f3 * rstd * w0.w);
            o.z = pk2(f4 * rstd * w1.x, f5 * rstd * w1.y); o.w = pk2(f6 * rstd * w1.z, f7 * rstd * w1.w); *mp = o; } }
        __syncthreads();
    }
}
__device__ __forceinline__ void ssd_c3f(const Args& a, Frame& F) {
    const unsigned char* ws = a.ws;
    const float* Dsk = (const float*)a.in[8]; const float* snw = (const float*)a.in[9];
    LAS unsigned char* BL = F.lds + RING_OFF; LAS unsigned char* CL = BL + 65536; LAS float* csl = (LAS float*)(F.lds + CSL_OFF + F.wave * 2048); LAS float* dtl = csl + 256;
    const int lane = F.lane, r = lane & 31, hh = lane >> 5, wave = F.wave;
    for (int uu = (int)blockIdx.x; uu < 256 * RPF(5); uu += F.G) { const int u = uu & 255;
        const int c = u >> 2, g = u & 3, t0 = c * 256, h = g * 8 + wave;
        { v4u st[16];
#pragma unroll
          for (int i = 0; i < 16; ++i) { const int piece = F.tid + 512 * i, which = piece >> 12, p2 = piece & 4095, row = p2 >> 4, ch = p2 & 15;
              st[i] = ldg16(ws + WS_XBC, ((unsigned)(t0 + row) * NCONV + 2048 + which * 512 + g * 128 + ch * 8) * 2u); }
          __syncthreads();
#pragma unroll
          for (int i = 0; i < 16; ++i) { const int piece = F.tid + 512 * i, which = piece >> 12, p2 = piece & 4095, row = p2 >> 4, ch = p2 & 15;
              *(LAS v4u*)(BL + which * 65536 + row * 256 + ((ch ^ (row & 15)) << 4)) = st[i]; } }
        { const unsigned o4 = (unsigned)(h * T + t0 + 4 * lane) * 4u;
          *(LAS f32x4*)(csl + 4 * lane) = *(const f32x4*)(ws + WS_CS + o4); *(LAS f32x4*)(dtl + 4 * lane) = *(const f32x4*)(ws + WS_DT + o4); }
        bf16x8 pf[2][8];
#pragma unroll
        for (int pt = 0; pt < 2; ++pt) { const unsigned po = (unsigned)(((c * 32 + h) * 64 + pt * 32 + r) * 128 + 8 * hh) * 2u;
#pragma unroll
            for (int kn = 0; kn < 8; ++kn) pf[pt][kn] = __builtin_bit_cast(bf16x8, ldg16(ws + WS_PREV, po + 32 * kn)); }
        __syncthreads();
        const unsigned xrow = (unsigned)(((h * 2) * 64 + c) * 16) * 1024u + lane * 16u;
        v4u xn[2][2];
#pragma unroll
        for (int pt = 0; pt < 2; ++pt)
#pragma unroll
            for (int k2 = 0; k2 < 2; ++k2) xn[pt][k2] = ldg16(ws + WS_XBT, xrow + (unsigned)pt * (64u * 16 * 1024) + (unsigned)k2 * 1024u);
#pragma unroll 1
        for (int lt = 0; lt < 8; ++lt) {
            const int lrow = lt * 32 + r; const float csv = csl[lrow];
            const LAS unsigned char* crow = CL + lrow * 256; const int cx = lrow & 15;
#define CFR(kn) (*(const LAS bf16x8*)(crow + (((2 * (kn) + hh) ^ cx) << 4)))
            f32x16 y[2];
#pragma unroll
            for (int pt = 0; pt < 2; ++pt) {
#pragma unroll
                for (int i = 0; i < 16; ++i) y[pt][i] = 0.f;
#pragma unroll
                for (int kn = 0; kn < 8; ++kn) y[pt] = __builtin_amdgcn_mfma_f32_32x32x16_bf16(CFR(kn), pf[pt][kn], y[pt], 0, 0, 0); }
#pragma unroll
            for (int i = 0; i < 16; ++i) { const float el = __expf(csl[lt * 32 + 4 * hh + (i & 3) + 8 * (i >> 2)]); y[0][i] *= el; y[1][i] *= el; }
#pragma unroll 1
            for (int st = 0; st <= lt; ++st) {
                v4u xl[2][2];
#pragma unroll
                for (int pt = 0; pt < 2; ++pt)
#pragma unroll
                    for (int k2 = 0; k2 < 2; ++k2) xl[pt][k2] = xn[pt][k2];
                { const int nst = st < lt ? st + 1 : 0;
#pragma unroll
                  for (int pt = 0; pt < 2; ++pt)
#pragma unroll
                      for (int k2 = 0; k2 < 2; ++k2) xn[pt][k2] = ldg16(ws + WS_XBT, xrow + (unsigned)pt * (64u * 16 * 1024) + (unsigned)(2 * nst + k2) * 1024u); }
                f32x16 S;
#pragma unroll
                for (int i = 0; i < 16; ++i) S[i] = 0.f;
                const int srow = st * 32 + r; int cxo = cx; asm volatile("" : "+v"(cxo));
                {
                  bf16x8 bq = *(const LAS bf16x8*)(BL + srow * 256 + (((hh) ^ (srow & 15)) << 4)), cq = *(const LAS bf16x8*)(crow + (((hh) ^ cxo) << 4));
#pragma unroll
                  for (int kn = 0; kn < 8; ++kn) { bf16x8 bn = bq, cn = cq;
                      if (kn < 7) { bn = *(const LAS bf16x8*)(BL + srow * 256 + (((2 * (kn + 1) + hh) ^ (srow & 15)) << 4)); cn = *(const LAS bf16x8*)(crow + (((2 * (kn + 1) + hh) ^ cxo) << 4)); }
                      S = __builtin_amdgcn_mfma_f32_32x32x16_bf16(bq, cq, S, 0, 0, 0); bq = bn; cq = cn; } }
                float m[16];
#pragma unroll
                for (int i4 = 0; i4 < 4; ++i4) { const int sb = st * 32 + 4 * hh + 8 * i4; const f32x4 c4 = *(const LAS f32x4*)(csl + sb), d4 = *(const LAS f32x4*)(dtl + sb);
                    m[4 * i4] = S[4 * i4] * __expf(csv - c4.x) * d4.x; m[4 * i4 + 1] = S[4 * i4 + 1] * __expf(csv - c4.y) * d4.y; m[4 * i4 + 2] = S[4 * i4 + 2] * __expf(csv - c4.z) * d4.z; m[4 * i4 + 3] = S[4 * i4 + 3] * __expf(csv - c4.w) * d4.w; }
                if (st == lt) {
#pragma unroll
                    for (int i = 0; i < 16; ++i) m[i] = (4 * hh + (i & 3) + 8 * (i >> 2) <= r) ? m[i] : 0.f; }
#pragma unroll
                for (int k2 = 0; k2 < 2; ++k2) { v4u bo; bo.x = cvtpk(m[8 * k2], m[8 * k2 + 1]); bo.y = cvtpk(m[8 * k2 + 2], m[8 * k2 + 3]); bo.z = cvtpk(m[8 * k2 + 4], m[8 * k2 + 5]); bo.w = cvtpk(m[8 * k2 + 6], m[8 * k2 + 7]);
#pragma unroll
                    for (int pt = 0; pt < 2; ++pt) { v4u xa = xl[pt][k2];
                        { const auto r0 = __builtin_amdgcn_permlane32_swap(xa.x, xa.z, false, false); xa.x = r0[0]; xa.z = r0[1]; const auto r1 = __builtin_amdgcn_permlane32_swap(xa.y, xa.w, false, false); xa.y = r1[0]; xa.w = r1[1]; }
                        y[pt] = __builtin_amdgcn_mfma_f32_32x32x16_bf16(__builtin_bit_cast(bf16x8, bo), __builtin_bit_cast(bf16x8, xa), y[pt], 0, 0, 0); } }
            }
#undef CFR
            { unsigned lmo = ((unsigned)(4 * hh) * DMIX + h * 64 + r) * 2u; asm volatile("" : "+v"(lmo));
#pragma unroll
              for (int i = 0; i < 16; ++i) { unsigned char* rp = (unsigned char*)a.ws + WS_MIX + (size_t)(t0 + lt * 32 + (i & 3) + 8 * (i >> 2)) * (DMIX * 2) + lmo;
                  *(bf16*)rp = (bf16)f2bf(y[0][i]); *(bf16*)(rp + 64) = (bf16)f2bf(y[1][i]); } }
        }
        __syncthreads();
        { const f32x4 w0 = *(const f32x4*)(snw + g * 512 + lane * 8), w1 = *(const f32x4*)(snw + g * 512 + lane * 8 + 4); const float dsk = Dsk[g * 8 + (lane >> 3)];
          v4u qb[4], xb[4], zb[4];
#define C3_SWEEP_LOADS(Q_, X_, Z_, tb_) { _Pragma("unroll") for (int k = 0; k < 4; ++k) { const unsigned tl_ = (unsigned)(t0 + wave * 32 + 4 * (tb_) + k); \
              Q_[k] = ldg16(ws + WS_MIX, (tl_ * DMIX + g * 512 + lane * 8) * 2u); X_[k] = ldg16(ws + WS_XBC, (tl_ * NCONV + g * 512 + lane * 8) * 2u); Z_[k] = ldg16(ws + WS_PROJ, (tl_ * NPROJ + g * 512 + lane * 8) * 2u); } }
          C3_SWEEP_LOADS(qb, xb, zb, 0);
#pragma unroll 1
          for (int tb = 0; tb < 8; ++tb) {
          v4u qn[4], xn[4], zn[4];
          C3_SWEEP_LOADS(qn, xn, zn, (tb < 7 ? tb + 1 : tb));
#pragma unroll
          for (int k = 0; k < 4; ++k) { const unsigned tl = (unsigned)(t0 + wave * 32 + 4 * tb + k);
            v4u* mp = (v4u*)((unsigned char*)a.ws + WS_MIX + (tl * DMIX + g * 512 + lane * 8) * 2u); const v4u q = qb[k];
            const v4u xv = xb[k], zv = zb[k];
            const float f0 = (bflo(q.x) + dsk * bflo(xv.x)) * silu(bflo(zv.x)), f1 = (bfhi(q.x) + dsk * bfhi(xv.x)) * silu(bfhi(zv.x)), f2 = (bflo(q.y) + dsk * bflo(xv.y)) * silu(bflo(zv.y)), f3 = (bfhi(q.y) + dsk * bfhi(xv.y)) * silu(bfhi(zv.y));
            const float f4 = (bflo(q.z) + dsk * bflo(xv.z)) * silu(bflo(zv.z)), f5 = (bfhi(q.z) + dsk * bfhi(xv.z)) * silu(bfhi(zv.z)), f6 = (bflo(q.w) + dsk * bflo(xv.w)) * silu(bflo(zv.w)), f7 = (bfhi(q.w) + dsk * bfhi(xv.w)) * silu(bfhi(zv.w));
            const float tot = wave_sum((f0 * f0 + f1 * f1) + (f2 * f2 + f3 * f3) + (f4 * f4 + f5 * f5) + (f6 * f6 + f7 * f7));
            const float rstd = __builtin_amdgcn_rsqf(tot * (1.0f / 512.0f) + EPS); v4u o;
            o.x = pk2(f0 * rstd * w0.x, f1 * rstd * w0.y); o.y = pk2(f2 * rstd * w0.z, f3 * rstd * w0.w);
            o.z = pk2(f4 * rstd * w1.x, f5 * rstd * w1.y); o.w = pk2(f6 * rstd * w1.z, f7 * rstd * w1.w); *mp = o; }
#pragma unroll
          for (int k = 0; k < 4; ++k) { qb[k] = qn[k]; xb[k] = xn[k]; zb[k] = zn[k]; }
          }
#undef C3_SWEEP_LOADS
        }
        __syncthreads();
    }
}
typedef float v2f_t __attribute__((ext_vector_type(2)));
typedef short v4i16_t __attribute__((ext_vector_type(4)));
__device__ __forceinline__ v4i16_t lds_tr16(LAS unsigned char* p) { return __builtin_amdgcn_ds_read_tr16_b64_v4i16((LAS v4i16_t*)p); }
__device__ __forceinline__ void attn_mfma(const Args& a, Frame& F) {
    const unsigned char* ws = a.ws;
    LAS unsigned char* KL = F.lds + RING_OFF; LAS unsigned char* VL = KL + 384 * 144;
    const int lane = F.lane, r = lane & 31, hh = lane >> 5, wave = F.wave;
    const int trb = (4 * hh + ((lane & 15) >> 2)) * 144 + ((lane >> 4) & 1) * 32 + (lane & 3) * 8;
    const float NEG = -__builtin_inff();
    v4u st[12];
#define ATTN_STAGE_LOADS(ITEM) do { const int it_ = (ITEM) >= 3072 ? (ITEM) - 3072 : (ITEM); const int br_ = it_ >> 10, x_ = it_ & 1023, h_ = x_ & 15, y_ = x_ >> 4, dsh_ = 2 * br_, d_ = 1 << dsh_, res_ = y_ & (d_ - 1), n0b_ = (y_ >> dsh_) * 256; \
        _Pragma("unroll") for (int i = 0; i < 12; ++i) { const int piece = F.tid + 512 * i, which = piece >= 3072, p2 = piece - which * 3072, row = p2 >> 3, c = p2 & 7; int n = n0b_ - 128 + row; n = n < 0 ? 0 : n; \
            st[i] = ldg16(ws + WS_PROJ, ((unsigned)((n << dsh_) + res_) * NPROJ + 6144 + which * 1024 + h_ * 64 + 8 * c) * 2u); } } while (0)
    if ((int)blockIdx.x < 3072 * RPF(3)) ATTN_STAGE_LOADS((int)blockIdx.x);
    for (int itt = (int)blockIdx.x; itt < 3072 * RPF(3); itt += F.G) { const int it = itt >= 3072 ? itt - 3072 : itt;
        const int br = it >> 10, x = it & 1023, h = x & 15, y = x >> 4;
        const int dsh = 2 * br, d = 1 << dsh, res = y & (d - 1), n0b = (y >> dsh) * 256, n0 = n0b + 32 * wave;
        const int tq = ((n0 + r) << dsh) + res;
        bf16x8 qf[4];
        { const unsigned qo = ((unsigned)tq * NPROJ + 5120 + h * 64 + 8 * hh) * 2u;
#pragma unroll
          for (int ks = 0; ks < 4; ++ks) qf[ks] = __builtin_bit_cast(bf16x8, ldg16(ws + WS_PROJ, qo + 32 * ks)); }
        { __syncthreads();
#pragma unroll
          for (int i = 0; i < 12; ++i) { const int piece = F.tid + 512 * i, which = piece >= 3072, p2 = piece - which * 3072, row = p2 >> 3, c = p2 & 7;
              *(LAS v4u*)(KL + which * (384 * 144) + row * 144 + 16 * c) = st[i]; }
          __syncthreads();
          if (itt + F.G < 3072 * RPF(3)) ATTN_STAGE_LOADS(itt + F.G); }
        f32x16 S[5];
#pragma unroll
        for (int kt = 0; kt < 5; ++kt) {
            const LAS unsigned char* kp = KL + (32 * wave + 32 * kt + r) * 144 + 16 * hh;
#pragma unroll
            for (int i = 0; i < 16; ++i) S[kt][i] = 0.f;
            { bf16x8 kq = *(const LAS bf16x8*)(kp);
#pragma unroll
              for (int ks = 0; ks < 4; ++ks) { bf16x8 kn_ = kq; if (ks < 3) kn_ = *(const LAS bf16x8*)(kp + 32 * (ks + 1)); __builtin_amdgcn_sched_barrier(0); S[kt] = __builtin_amdgcn_mfma_f32_32x32x16_bf16(kq, qf[ks], S[kt], 0, 0, 0); kq = kn_; } }
        }
#pragma unroll
        for (int i = 0; i < 16; ++i) { const int j = (i & 3) + 8 * (i >> 2) + 4 * hh; S[0][i] = (j >= r) ? S[0][i] : NEG; S[4][i] = (j <= r) ? S[4][i] : NEG; }
        if (n0 < 128) {
#pragma unroll
            for (int kt = 0; kt < 4; ++kt)
#pragma unroll
                for (int i = 0; i < 16; ++i) { const int j = (i & 3) + 8 * (i >> 2) + 4 * hh; S[kt][i] = (n0 - 128 + 32 * kt + j >= 0) ? S[kt][i] : NEG; }
        }
        float m = NEG;
#pragma unroll
        for (int kt = 0; kt < 5; ++kt)
#pragma unroll
            for (int i = 0; i < 16; ++i) m = fmaxf(m, S[kt][i]);
        m = fmaxf(m, __shfl_xor(m, 32));
        v2f_t l2 = {0.f, 0.f}; const v2f_t m2 = {m, m};
#pragma unroll
        for (int kt = 0; kt < 5; ++kt)
#pragma unroll
            for (int i = 0; i < 16; i += 2) { v2f_t x = {S[kt][i], S[kt][i + 1]}; x = x - m2; x.x = __builtin_amdgcn_exp2f(x.x); x.y = __builtin_amdgcn_exp2f(x.y); l2 += x; S[kt][i] = x.x; S[kt][i + 1] = x.y; }
        float l = l2.x + l2.y;
        l += __shfl_xor(l, 32);
        f32x16 O[2];
#pragma unroll
        for (int i = 0; i < 16; ++i) { O[0][i] = 0.f; O[1][i] = 0.f; }
#pragma unroll
        for (int kt = 0; kt < 5; ++kt) {
            LAS unsigned char* vp = VL + (32 * wave + 32 * kt) * 144 + trb;
#pragma unroll
            for (int s2 = 0; s2 < 2; ++s2) {
                v4u pb; pb.x = cvtpk(S[kt][8 * s2], S[kt][8 * s2 + 1]); pb.y = cvtpk(S[kt][8 * s2 + 2], S[kt][8 * s2 + 3]); pb.z = cvtpk(S[kt][8 * s2 + 4], S[kt][8 * s2 + 5]); pb.w = cvtpk(S[kt][8 * s2 + 6], S[kt][8 * s2 + 7]);
#pragma unroll
                for (int dvt = 0; dvt < 2; ++dvt) {
                    const v4i16_t lo = lds_tr16(vp + (16 * s2) * 144 + dvt * 64), hi = lds_tr16(vp + (16 * s2 + 8) * 144 + dvt * 64);
                    const bf16x8 af = {lo[0], lo[1], lo[2], lo[3], hi[0], hi[1], hi[2], hi[3]};
                    O[dvt] = __builtin_amdgcn_mfma_f32_32x32x16_bf16(__builtin_bit_cast(bf16x8, pb), af, O[dvt], 0, 0, 0); } }
        }
        const float inv = 1.0f / l;
#pragma unroll
        for (int i = 0; i < 16; ++i) { const int qi = (i & 3) + 8 * (i >> 2) + 4 * hh;
            const float invq = __shfl(inv, qi);
            const unsigned oo = (((unsigned)br * T + (((n0 + qi) << dsh) + res)) * 1024u + h * 64 + r) * 2u;
            *(bf16*)((unsigned char*)a.ws + WS_OP + oo) = (bf16)f2bf(O[0][i] * invq); *(bf16*)((unsigned char*)a.ws + WS_OP + oo + 64) = (bf16)f2bf(O[1][i] * invq); }
        if (hh == 0) { float2 ml; ml.x = m; ml.y = l; *(float2*)((unsigned char*)a.ws + WS_ML + (((unsigned)br * T + tq) * 16u + h) * 8u) = ml; }
    }
    __syncthreads();
}
#undef ATTN_STAGE_LOADS
__device__ __forceinline__ void attn_combine(const Args& a, Frame& F) {
    const unsigned char* ws = a.ws; const int lane = F.lane, h = lane >> 2, sub = lane & 3;
    float2 mlc[3]; v4u uc[3][2]; int tt = F.gw;
#define AC_LOAD(ML_, U_, t_) { _Pragma("unroll") for (int b = 0; b < 3; ++b) { ML_[b] = *(const float2*)(ws + WS_ML + (((unsigned)b * T + (t_)) * 16u + h) * 8u); \
            const unsigned off = (((unsigned)b * T + (t_)) * 1024u + h * 64 + sub * 16) * 2u; U_[b][0] = ldg16(ws + WS_OP, off); U_[b][1] = ldg16(ws + WS_OP, off + 16); } }
    if (tt < T * RPF(4)) AC_LOAD(mlc, uc, tt & (T - 1));
#pragma unroll 1
    for (; tt < T * RPF(4); tt += F.NGW) { const int t = tt & (T - 1);
        float2 mln[3]; v4u un[3][2];
        { const int tn = (tt + F.NGW < T * RPF(4)) ? ((tt + F.NGW) & (T - 1)) : t; AC_LOAD(mln, un, tn); }
        float mb[3], lb[3];
#pragma unroll
        for (int b = 0; b < 3; ++b) { mb[b] = mlc[b].x; lb[b] = mlc[b].y; }
        const float M = fmaxf(mb[0], fmaxf(mb[1], mb[2]));
        const float w0 = __builtin_amdgcn_exp2f(mb[0] - M) * lb[0], w1 = __builtin_amdgcn_exp2f(mb[1] - M) * lb[1], w2 = __builtin_amdgcn_exp2f(mb[2] - M) * lb[2]; const float iw = 1.0f / (w0 + w1 + w2);
        const float wb[3] = {w0 * iw, w1 * iw, w2 * iw};
        float o[16];
#pragma unroll
        for (int i = 0; i < 16; ++i) o[i] = 0.f;
#pragma unroll
        for (int b = 0; b < 3; ++b) { const v4u u0 = uc[b][0], u1 = uc[b][1];
            o[0] += wb[b] * bflo(u0.x); o[1] += wb[b] * bfhi(u0.x); o[2] += wb[b] * bflo(u0.y); o[3] += wb[b] * bfhi(u0.y); o[4] += wb[b] * bflo(u0.z); o[5] += wb[b] * bfhi(u0.z); o[6] += wb[b] * bflo(u0.w); o[7] += wb[b] * bfhi(u0.w);
            o[8] += wb[b] * bflo(u1.x); o[9] += wb[b] * bfhi(u1.x); o[10] += wb[b] * bflo(u1.y); o[11] += wb[b] * bfhi(u1.y); o[12] += wb[b] * bflo(u1.z); o[13] += wb[b] * bfhi(u1.z); o[14] += wb[b] * bflo(u1.w); o[15] += wb[b] * bfhi(u1.w); }
        v4u q0, q1; q0.x = pk2(o[0], o[1]); q0.y = pk2(o[2], o[3]); q0.z = pk2(o[4], o[5]); q0.w = pk2(o[6], o[7]); q1.x = pk2(o[8], o[9]); q1.y = pk2(o[10], o[11]); q1.z = pk2(o[12], o[13]); q1.w = pk2(o[14], o[15]);
        v4u* dst = (v4u*)((unsigned char*)a.ws + WS_MIX + ((unsigned)t * DMIX + 2048 + h * 64 + sub * 16) * 2u); dst[0] = q0; dst[1] = q1;
#pragma unroll
        for (int b = 0; b < 3; ++b) { mlc[b] = mln[b]; uc[b][0] = un[b][0]; uc[b][1] = un[b][1]; }
    }
#undef AC_LOAD
}

__device__ __forceinline__ void p7_router(const Args& a, Frame& F) {
    const float* hres = a.out; const float* n2w = (const float*)a.in[13];
    const float* bgr = (const float*)a.in[15]; const float* ber = (const float*)a.in[17];
    const bf16* WRH = (const bf16*)(a.ws + WS_WR); const bf16* WRL = WRH + 80 * D;
    int* EID = (int*)(a.ws + WS_EID); float* GATE = (float*)(a.ws + WS_GATE); int* POS = (int*)(a.ws + WS_POS); int* HIST = (int*)(a.ws + WS_HIST); float* RSTD = (float*)(a.ws + WS_RSTD);
    LAS float* part = (LAS float*)(F.lds + RING_OFF); LAS float* ssl = (LAS float*)(F.lds + RING_OFF + 81920); LAS float* lg = (LAS float*)(F.lds + RING_OFF + 83968); LAS int* hl = (LAS int*)(F.lds + TAB_OFF);
    if (F.tid < 64) hl[F.tid] = 0;
    __syncthreads();
    const int lane = F.lane, row = lane & 15, g4 = lane >> 4, k0 = F.wave * 256;
    for (int it = (int)blockIdx.x; it < T / 32; it += F.G) {
        const int t0 = it * 32;
        const float* hrow = hres + (size_t)(t0 + row) * D + k0 + 8 * g4; const float* wrow = n2w + k0 + 8 * g4;
        const bf16* bh0 = WRH + (size_t)(F.wave * 8) * 512 + lane * 8; const bf16* bl0 = WRL + (size_t)(F.wave * 8) * 512 + lane * 8;
        unsigned char* h8row = (unsigned char*)(a.ws + WS_HN8) + (size_t)(t0 + row) * D + k0 + 8 * g4;
        f32x4 acc[2][5]; float ss[2] = {0.f, 0.f};
#pragma unroll
        for (int rt = 0; rt < 2; ++rt)
#pragma unroll
            for (int ct = 0; ct < 5; ++ct) acc[rt][ct] = (f32x4){0.f, 0.f, 0.f, 0.f};
#pragma unroll 1
        for (int kh = 0; kh < 2; ++kh) {
        unsigned long long h8v[2][4];
#pragma unroll
        for (int k4 = 0; k4 < 4; ++k4) { const int ks = kh * 4 + k4;
            const f32x4 w0 = *(const f32x4*)(wrow + 32 * ks), w1 = *(const f32x4*)(wrow + 32 * ks + 4);
            bf16x8 ah[2], al[2];
#pragma unroll
            for (int rt = 0; rt < 2; ++rt) {
                const f32x4 a0 = *(const f32x4*)(hrow + (size_t)(rt * 16) * D + 32 * ks), a1 = *(const f32x4*)(hrow + (size_t)(rt * 16) * D + 32 * ks + 4);
                ss[rt] += (a0.x * a0.x + a0.y * a0.y) + (a0.z * a0.z + a0.w * a0.w) + (a1.x * a1.x + a1.y * a1.y) + (a1.z * a1.z + a1.w * a1.w);
                const f32x4 v0 = a0 * w0, v1 = a1 * w1;
                v4u hi; hi.x = cvtpk(v0.x, v0.y); hi.y = cvtpk(v0.z, v0.w); hi.z = cvtpk(v1.x, v1.y); hi.w = cvtpk(v1.z, v1.w);
                v4u lo; lo.x = cvtpk(v0.x - bflo(hi.x), v0.y - bfhi(hi.x)); lo.y = cvtpk(v0.z - bflo(hi.y), v0.w - bfhi(hi.y)); lo.z = cvtpk(v1.x - bflo(hi.z), v1.y - bfhi(hi.z)); lo.w = cvtpk(v1.z - bflo(hi.w), v1.w - bfhi(hi.w));
                h8v[rt][k4] = (unsigned long long)fp8x4(v0.x, v0.y, v0.z, v0.w) | ((unsigned long long)fp8x4(v1.x, v1.y, v1.z, v1.w) << 32);
                ah[rt] = __builtin_bit_cast(bf16x8, hi); al[rt] = __builtin_bit_cast(bf16x8, lo); }
#pragma unroll
            for (int ct = 0; ct < 5; ++ct) { const bf16x8 bh = *(const bf16x8*)(bh0 + (size_t)(ct * 64 + ks) * 512), bl = *(const bf16x8*)(bl0 + (size_t)(ct * 64 + ks) * 512);
#pragma unroll
                for (int rt = 0; rt < 2; ++rt) { acc[rt][ct] = __builtin_amdgcn_mfma_f32_16x16x32_bf16(ah[rt], bh, acc[rt][ct], 0, 0, 0); acc[rt][ct] = __builtin_amdgcn_mfma_f32_16x16x32_bf16(ah[rt], bl, acc[rt][ct], 0, 0, 0); acc[rt][ct] = __builtin_amdgcn_mfma_f32_16x16x32_bf16(al[rt], bh, acc[rt][ct], 0, 0, 0); } }
        }
#if MOE_FP8
#pragma unroll
        for (int rt = 0; rt < 2; ++rt)
#pragma unroll
            for (int k4 = 0; k4 < 4; ++k4) *(unsigned long long*)(h8row + (size_t)(rt * 16) * D + 32 * (kh * 4 + k4)) = h8v[rt][k4];
#endif
        }
#pragma unroll
        for (int rt = 0; rt < 2; ++rt) { ss[rt] += __shfl_xor(ss[rt], 16); ss[rt] += __shfl_xor(ss[rt], 32); }
#pragma unroll
        for (int rt = 0; rt < 2; ++rt)
#pragma unroll
            for (int ct = 0; ct < 5; ++ct)
#pragma unroll
                for (int r = 0; r < 4; ++r) part[F.wave * 2560 + (rt * 16 + g4 * 4 + r) * 80 + ct * 16 + row] = acc[rt][ct][r];
        if (g4 == 0) { ssl[F.wave * 32 + row] = ss[0]; ssl[F.wave * 32 + 16 + row] = ss[1]; }
        __syncthreads();
        for (int idx = F.tid; idx < 2560; idx += NWAVES * 64) { float v = 0.f;
#pragma unroll
            for (int w = 0; w < 8; ++w) v += part[w * 2560 + idx];
            lg[idx] = v; }
        __syncthreads();
        if (F.tid < 32) { const int t = t0 + F.tid; const LAS float* q = lg + F.tid * 80;
            float sq = 0.f;
#pragma unroll
            for (int w = 0; w < 8; ++w) sq += ssl[w * 32 + F.tid];
            const float rstd = 1.0f / sqrtf(sq * (1.0f / D) + EPS); RSTD[t] = rstd;
            float gmax = -__builtin_inff(); int gi = 0; float gl[8];
#pragma unroll
            for (int c = 0; c < 8; ++c) { gl[c] = q[c] * rstd + bgr[c]; if (gl[c] > gmax) { gmax = gl[c]; gi = c; } }
            float gsum = 0.f;
#pragma unroll
            for (int c = 0; c < 8; ++c) gsum += expf(gl[c] - gmax);
            const float gval = 1.0f / gsum;
            float e1 = -__builtin_inff(), e2 = -__builtin_inff(); int i1 = 0, i2 = 0; float el[8];
#pragma unroll
            for (int c = 0; c < 8; ++c) { el[c] = q[8 + gi * 8 + c] * rstd + ber[gi * 8 + c]; if (el[c] > e1) { e1 = el[c]; i1 = c; } }
#pragma unroll
            for (int c = 0; c < 8; ++c) { if (c != i1 && el[c] > e2) { e2 = el[c]; i2 = c; } }
            const float rr = expf(e2 - e1); const float w1 = 1.0f / (1.0f + rr), w2 = rr / (1.0f + rr);
            const int ea = gi * 8 + i1, eb = gi * 8 + i2;
            const int pa = __hip_atomic_fetch_add(hl + ea, 1, __ATOMIC_RELAXED, __HIP_MEMORY_SCOPE_WORKGROUP), pb = __hip_atomic_fetch_add(hl + eb, 1, __ATOMIC_RELAXED, __HIP_MEMORY_SCOPE_WORKGROUP);
            EID[2 * t] = ea; EID[2 * t + 1] = eb; GATE[2 * t] = gval * w1; GATE[2 * t + 1] = gval * w2; POS[2 * t] = ((int)blockIdx.x << 16) | pa; POS[2 * t + 1] = ((int)blockIdx.x << 16) | pb; }
        __syncthreads();
    }
    if (F.tid < 64) HIST[(int)blockIdx.x * 64 + F.tid] = hl[F.tid];
}

__device__ __forceinline__ void p8_offsets(const Args& a, Frame& F) {
    LAS int* tab = (LAS int*)(F.lds + TAB_OFF); LAS int* bt = (LAS int*)(F.lds + RING_OFF);
    const int* HIST = (const int*)(a.ws + WS_HIST);
    for (int i = F.tid; i < 256 * 64; i += NWAVES * 64) bt[i] = (i < F.G * 64) ? HIST[i] : 0;
    __syncthreads();
    if (F.tid < 64) { int run = 0; for (int b = 0; b < 256; ++b) { const int c = bt[b * 64 + F.tid]; bt[b * 64 + F.tid] = run; run += c; } tab[128 + F.tid] = run; tab[192 + F.tid] = (run + 255) & ~255; }
    __syncthreads();
    if (F.tid == 0) { int run = 0; for (int e = 0; e < 64; ++e) { tab[e] = run; run += tab[192 + e]; } tab[64] = run; }
    __syncthreads();
}
__device__ __forceinline__ void p8_gather(const Args& a, Frame& F) {
    p8_offsets(a, F);
    LAS int* tab = (LAS int*)(F.lds + TAB_OFF); LAS int* bt = (LAS int*)(F.lds + RING_OFF);
    const int R = tab[64];
    int* TILE = (int*)(a.ws + WS_TILE);
    if (blockIdx.x == 0) {
        for (int pm = F.tid; pm < R / 256; pm += NWAVES * 64) { int e = 0; for (int q = 1; q < 64; ++q) if (tab[q] <= pm * 256) e = q; TILE[pm] = e; }
        if (F.tid == 0) TILE[255] = R / 256;
    }
    const float* hres = a.out; const float* n2w = (const float*)a.in[13]; const float* RSTD = (const float*)(a.ws + WS_RSTD); bf16* XG = (bf16*)(a.ws + WS_XG);
    const int* EID = (const int*)(a.ws + WS_EID); const int* POS = (const int*)(a.ws + WS_POS); int* DEST = (int*)(a.ws + WS_DEST);
    for (int ass = F.gw; ass < 2 * T * RPF(8); ass += F.NGW) { const int as = ass & (2 * T - 1);
        const int e = EID[as], pp = POS[as], dest = tab[e] + bt[(pp >> 16) * 64 + e] + (pp & 0xffff);
        if (F.lane == 0) { DEST[as] = dest; ((float*)(a.ws + WS_ROWRS))[dest] = RSTD[as >> 1]; }
#if MOE_FP8
        { const v4u* s8 = (const v4u*)((const unsigned char*)(a.ws + WS_HN8) + (size_t)(as >> 1) * D) + F.lane; const v4u q0 = s8[0], q1 = s8[64];
          v4u* d8 = (v4u*)((unsigned char*)XG + (size_t)dest * D) + F.lane; d8[0] = q0; d8[64] = q1; }
#else
        { const int t = as >> 1; const float rstd = RSTD[t]; const GAS f32x4* xr = (const GAS f32x4*)(hres + (size_t)t * D) + F.lane; const GAS f32x4* wr = (const GAS f32x4*)n2w + F.lane;
          GAS unsigned long long* o8 = (GAS unsigned long long*)(XG + (size_t)dest * D) + F.lane;
#pragma unroll
          for (int j = 0; j < 8; ++j) { const f32x4 o = xr[64 * j] * rstd * wr[64 * j]; o8[64 * j] = (unsigned long long)pk2(o.x, o.y) | ((unsigned long long)pk2(o.z, o.w) << 32); } }
#endif
    }
}
__device__ __forceinline__ int moe_slot(const Frame& F) { const int c = (int)blockIdx.x; return (F.G & 7) ? c : (c & 7) * (F.G >> 3) + (c >> 3); }
__device__ __forceinline__ int moe_tiles_to_lds(const Args& a, Frame& F) {
    LAS int* tab = (LAS int*)(F.lds + TAB_OFF); const int* TILE = (const int*)(a.ws + WS_TILE);
    if (F.tid < 256) tab[F.tid] = TILE[F.tid];
    __syncthreads();
    return __builtin_amdgcn_readfirstlane(tab[255]);
}

__device__ __forceinline__ void p11_combine(const Args& a, Frame& F) {
#if MOE_FP8
    const unsigned char* Y = (const unsigned char*)(a.ws + WS_Y); const int* DEST = (const int*)(a.ws + WS_DEST); const float* GATE = (const float*)(a.ws + WS_GATE); float* out = a.out;
    for (int t = F.gw; t < T; t += F.NGW) {
        const int d0 = DEST[2 * t], d1 = DEST[2 * t + 1]; const float g0 = GATE[2 * t] * 0.125f, g1 = GATE[2 * t + 1] * 0.125f;
        GAS f32x4* o = (GAS f32x4*)(out + (size_t)t * D) + F.lane;
        const GAS unsigned* y0 = (const GAS unsigned*)(Y + (size_t)d0 * D) + F.lane; const GAS unsigned* y1 = (const GAS unsigned*)(Y + (size_t)d1 * D) + F.lane;
#pragma unroll
        for (int j = 0; j < 8; ++j) { f32x4 v = o[64 * j]; const unsigned u0 = y0[64 * j], u1 = y1[64 * j];
            const v2f_t a0 = __builtin_amdgcn_cvt_pk_f32_fp8((int)u0, false), a1 = __builtin_amdgcn_cvt_pk_f32_fp8((int)u0, true), b0 = __builtin_amdgcn_cvt_pk_f32_fp8((int)u1, false), b1 = __builtin_amdgcn_cvt_pk_f32_fp8((int)u1, true);
            v.x += g0 * a0.x + g1 * b0.x; v.y += g0 * a0.y + g1 * b0.y; v.z += g0 * a1.x + g1 * b1.x; v.w += g0 * a1.y + g1 * b1.y;
            o[64 * j] = v; }
    }
#else
    const bf16* Y = (const bf16*)(a.ws + WS_Y); const int* DEST = (const int*)(a.ws + WS_DEST); const float* GATE = (const float*)(a.ws + WS_GATE); float* out = a.out;
    for (int t = F.gw; t < T; t += F.NGW) {
        const int d0 = DEST[2 * t], d1 = DEST[2 * t + 1]; const float g0 = GATE[2 * t], g1 = GATE[2 * t + 1];
        GAS f32x4* o = (GAS f32x4*)(out + (size_t)t * D) + F.lane;
        const GAS unsigned long long* y0 = (const GAS unsigned long long*)(Y + (size_t)d0 * D) + F.lane; const GAS unsigned long long* y1 = (const GAS unsigned long long*)(Y + (size_t)d1 * D) + F.lane;
#pragma unroll
        for (int j = 0; j < 8; ++j) { f32x4 v = o[64 * j]; const unsigned long long u0 = y0[64 * j], u1 = y1[64 * j];
            v.x += g0 * bflo((unsigned)u0) + g1 * bflo((unsigned)u1); v.y += g0 * bfhi((unsigned)u0) + g1 * bfhi((unsigned)u1);
            v.z += g0 * bflo((unsigned)(u0 >> 32)) + g1 * bflo((unsigned)(u1 >> 32)); v.w += g0 * bfhi((unsigned)(u0 >> 32)) + g1 * bfhi((unsigned)(u1 >> 32));
            o[64 * j] = v; }
    }
#endif
}

constexpr int NPHASE = 12;
__global__ void __launch_bounds__(NWAVES * 64, 2) hymba_fwd(Args args) {
    extern __shared__ __attribute__((aligned(16))) unsigned char lds[];
    Frame F;
    F.lds = (LAS unsigned char*)lds;
    F.MISC = (volatile LAS unsigned*)(F.lds + MISC_OFF);
    F.tid = threadIdx.x; F.lane = F.tid & 63; F.wave = __builtin_amdgcn_readfirstlane(F.tid >> 6);
    F.G = gridDim.x; { const int bx = blockIdx.x; F.vcu = (F.G % 8 == 0) ? (bx % 8) * (F.G / 8) + bx / 8 : bx; }
    F.gw = F.vcu * NWAVES + F.wave; F.NGW = F.G * NWAVES;
    F.ctl = (gu32*)(args.ws + WS_CTL);
    for (int u = F.tid; u < (LDS_BYTES - LDSCTL_OFF) / 4; u += NWAVES * 64) ((LAS unsigned*)(F.lds + LDSCTL_OFF))[u] = 0u;
    __syncthreads();
    const int lo = args.ph_lo, hi = args.ph_hi;
    const bool fused = (hi - lo) > 1;
    XcdBarrier bar; bar.bar = (unsigned*)(F.ctl + CW_BAR); bar.x = 0; bar.st = nullptr;
    if (fused) bar = xcd_barrier_post((unsigned*)(F.ctl + CW_BAR), F.MISC + 8);
#define IN(k) (lo <= (k) && (k) < hi)
#define SEAM(k) do { if (IN(k) && IN((k) + 1)) xcd_barrier(bar); } while (0)
#define REPN(k) ((((REP_MASK) >> (k)) & 1) ? 2 : 1)
#define REPLOOP(k) _Pragma("unroll 1") for (int rp_ = 0; rp_ < REPN(k); ++rp_)
#define REPBAR() do { if (rp_) xcd_barrier(bar); } while (0)

    if (IN(0)) { p0_prologue(args, F); SEAM(0); }
    if (IN(1)) {
        const int bx = (int)blockIdx.x; const bool split = MOE_CONV_IN_P1 && F.G == 256; const bool conv = split && ((bx >> 3) & 3) == 3;
        if (MOE_CONV_IN_P1 && !split) moe_weight_items(args, F.gw, F.NGW, F.lane);
        if (conv) moe_weight_items(args, ((bx >> 5) * 8 + (bx & 7)) * NWAVES + F.wave, 64 * NWAVES, F.lane);
        else {
        constexpr int NBF = MOE_FP8 ? 5120 : NPROJ;
#if MOE_FP8 && P1_INTERLEAVE
        { pg8::Gemm g{(const pg8::bf16_t*)(args.ws + WS_HN), (const pg8::bf16_t*)(args.ws + WS_W1T), T, NBF, D}; pg8::StaticOrder SB; SB.init(T, NBF, F.G, bx);
          pg8::EpiBf16<0> E{(pg8::bf16_t*)(args.ws + WS_PROJ), NPROJ, nullptr, 0, 0, 1.f};
          pg8::Gemm g8{(const pg8::bf16_t*)(args.ws + WS_HN8), (const pg8::bf16_t*)(args.ws + WS_WQ8), T, 3072, D / 2}; pg8::StaticOrder S8; S8.init(T, 3072, F.G, bx);
          pg8::EpiBf16<0> E8{(pg8::bf16_t*)(args.ws + WS_PROJ) + 5120, NPROJ, nullptr, 0, 0, 1.f};
          const int nb16 = (T / 256) * (NBF / 256), n8 = (T / 256) * (3072 / 256);
          const int rb = (nb16 + F.G - 1) / F.G, r8 = (n8 + F.G - 1) / F.G, nr = rb + r8;
          const int ntile_all = (NT_ALL - NT_QKV - bx + F.G - 1) / F.G;
          const int ntile = (ntile_all * P1_SHARE + 99) / 100;
          const int per = (ntile + nr - 1) / nr; int tdone = 0; const bool conv_first = (bx & 1) != 0;
#pragma unroll 1
          for (int rr = 0; rr <= nr; ++rr) {
              { int want = (rr == nr) ? ntile : (conv_first ? rr + 1 : rr) * per; want = want < ntile ? want : ntile;
                if (want > tdone) { moe_weight_tiles(args, F, NT_QKV + bx + tdone * F.G, NT_QKV + bx + (want - 1) * F.G + 1); tdone = want; } }
              if (rr == nr) break;
              if (rr < rb) { pg8::OneUnit S1{SB, rr}; pg8::gemm_phase<pg8::EpiBf16<0>, pg8::OneUnit, true, true>(F.lds + RING_OFF, g, S1, E); }
              else { pg8::OneUnit S1{S8, rr - rb}; pg8::gemm_phase8<pg8::EpiBf16<0>, pg8::OneUnit, true, true, true>(F.lds + RING_OFF, g8, S1, E8, 121, 127); }
          } }
#else
        pg8::Gemm g{(const pg8::bf16_t*)(args.ws + WS_HN), (const pg8::bf16_t*)(args.ws + WS_W1T), T, NBF, D}; pg8::StaticOrder S; S.init(T, NBF, split ? 192 : F.G, split ? (bx >> 5) * 24 + (bx & 31) : bx);
        pg8::EpiBf16<0> E{(pg8::bf16_t*)(args.ws + WS_PROJ), NPROJ, nullptr, 0, 0, 1.f};
        pg8::gemm_phase<pg8::EpiBf16<0>, pg8::StaticOrder, true, true>(F.lds + RING_OFF, g, S, E);
#if MOE_FP8
        { pg8::Gemm g8{(const pg8::bf16_t*)(args.ws + WS_HN8), (const pg8::bf16_t*)(args.ws + WS_WQ8), T, 3072, D / 2}; pg8::StaticOrder S8; S8.init(T, 3072, F.G, bx);
          pg8::EpiBf16<0> E8{(pg8::bf16_t*)(args.ws + WS_PROJ) + 5120, NPROJ, nullptr, 0, 0, 1.f};
          pg8::gemm_phase8<pg8::EpiBf16<0>, pg8::StaticOrder, true, true, true>(F.lds + RING_OFF, g8, S8, E8, 121, 127); }
#endif
#endif
        }
        SEAM(1);
    }
    if (IN(2)) { p2_postproj(args, F); SEAM(2); }
    if (IN(3)) { attn_mfma(args, F); ssd_c1(args, F); SEAM(3); }
    if (IN(4)) { ssd_c2(args, F); attn_combine(args, F); SEAM(4); }
    if (IN(5)) {
#if C3_FLASH
        ssd_c3f(args, F);
#else
        ssd_c3(args, F);
#endif
        SEAM(5); }
    if (IN(6)) {
        pg8::Gemm g{(const pg8::bf16_t*)(args.ws + WS_MIX), (const pg8::bf16_t*)(args.ws + WS_WOT), T, D, DMIX}; pg8::StaticOrder S; S.init(T, D, F.G, (int)blockIdx.x);
        pg8::EpiResF32 E{(const float*)args.in[0], args.out, D};
#if MOE_FP8 && P1_INTERLEAVE
        { const int bx = (int)blockIdx.x; const int ntile_all = (NT_ALL - NT_QKV - bx + F.G - 1) / F.G, t0c = (ntile_all * P1_SHARE + 99) / 100, ntile = ntile_all - t0c;
          const int nu = ((T / 256) * (D / 256) + F.G - 1) / F.G; const int per = (ntile + nu - 1) / (nu > 0 ? nu : 1); int tdone = 0; const bool conv_first = (bx & 1) == 0;
#pragma unroll 1
          for (int rr = 0; rr <= nu; ++rr) {
              { int want = (rr == nu) ? ntile : (conv_first ? rr + 1 : rr) * per; want = want < ntile ? want : ntile;
                if (want > tdone) { moe_weight_tiles(args, F, NT_QKV + bx + (t0c + tdone) * F.G, NT_QKV + bx + (t0c + want - 1) * F.G + 1); tdone = want; } }
              if (rr == nu) break;
              pg8::OneUnit S1{S, rr}; pg8::gemm_phase<pg8::EpiResF32, pg8::OneUnit, true, true>(F.lds + RING_OFF, g, S1, E);
          } }
#else
        pg8::gemm_phase<pg8::EpiResF32, pg8::StaticOrder, true, true>(F.lds + RING_OFF, g, S, E);
#endif
        SEAM(6);
    }
    if (IN(7)) { REPLOOP(7) { REPBAR(); p7_router(args, F); } SEAM(7); }
    if (IN(8)) { p8_gather(args, F); SEAM(8); }
    if (IN(9)) {
        const int ntiles = moe_tiles_to_lds(args, F);
#if MOE_FP8
        pg8::Gemm g{(const pg8::bf16_t*)(args.ws + WS_XG), (const pg8::bf16_t*)(args.ws + WS_WGU), 0, 2048, D / 2};
        pg8::MoeOrder S{(const LAS int*)(F.lds + TAB_OFF), ntiles, 8, F.G, moe_slot(F), (size_t)2048 * D};
        pg8::EpiSwiglu8 E{(unsigned char*)(args.ws + WS_HID), DEXP, (const float*)(args.ws + WS_ROWRS)};
        pg8::gemm_phase8<pg8::EpiSwiglu8, pg8::MoeOrder, true, true, true>(F.lds + RING_OFF, g, S, E, 121, 127);
#else
        pg8::Gemm g{(const pg8::bf16_t*)(args.ws + WS_XG), (const pg8::bf16_t*)(args.ws + WS_WGU), 0, 2048, D};
        pg8::MoeOrder S{(const LAS int*)(F.lds + TAB_OFF), ntiles, 8, F.G, (int)blockIdx.x, (size_t)2048 * D * 2};
        pg8::EpiSwiglu E{(pg8::bf16_t*)(args.ws + WS_HID), DEXP};
        pg8::gemm_phase<pg8::EpiSwiglu, pg8::MoeOrder, true, true>(F.lds + RING_OFF, g, S, E);
#endif
        SEAM(9);
    }
    if (IN(10)) {
        const int ntiles = moe_tiles_to_lds(args, F);
#if MOE_FP8
        pg8::Gemm g{(const pg8::bf16_t*)(args.ws + WS_HID), (const pg8::bf16_t*)(args.ws + WS_WD), 0, D, DEXP / 2};
        pg8::MoeOrder S{(const LAS int*)(F.lds + TAB_OFF), ntiles, 8, F.G, moe_slot(F), (size_t)D * DEXP};
        pg8::EpiFp8 E{(unsigned char*)(args.ws + WS_Y), D, 8.f};
        pg8::gemm_phase8<pg8::EpiFp8, pg8::MoeOrder, true, true, true>(F.lds + RING_OFF, g, S, E, 121, 125);
#else
        pg8::Gemm g{(const pg8::bf16_t*)(args.ws + WS_HID), (const pg8::bf16_t*)(args.ws + WS_WD), 0, D, DEXP};
        pg8::MoeOrder S{(const LAS int*)(F.lds + TAB_OFF), ntiles, 8, F.G, (int)blockIdx.x, (size_t)D * DEXP * 2};
        pg8::EpiBf16<0> E{(pg8::bf16_t*)(args.ws + WS_Y), D, nullptr, 0, 0, 1.f};
        pg8::gemm_phase<pg8::EpiBf16<0>, pg8::MoeOrder, true, true>(F.lds + RING_OFF, g, S, E);
#endif
        SEAM(10);
    }
    if (IN(11)) { p11_combine(args, F); }
#undef IN
#undef SEAM
}

#ifndef ONE_LAUNCH
#define ONE_LAUNCH 1
#endif
extern "C" void kernel_launch(void* const* d_in, const int* in_sizes, int n_in, void* d_out, int out_size, void* d_ws, size_t ws_size, hipStream_t stream) {
    static int grid = 0;
    if (grid == 0) {
        if (n_in != 21 || out_size != T * D || ws_size < WS_END) { fprintf(stderr, "kernel_launch: unexpected shapes (n_in %d, out %d, ws %zu)\n", n_in, out_size, ws_size); grid = -1; return; }
        int dev = 0, cus = 0, per_cu = 0;
        if (hipGetDevice(&dev) != hipSuccess || hipDeviceGetAttribute(&cus, hipDeviceAttributeMultiprocessorCount, dev) != hipSuccess) { grid = -1; return; }
        if (hipFuncSetAttribute((const void*)hymba_fwd, hipFuncAttributeMaxDynamicSharedMemorySize, LDS_BYTES) != hipSuccess) { fprintf(stderr, "kernel_launch: hipFuncSetAttribute failed\n"); grid = -1; return; }
        if (hipOccupancyMaxActiveBlocksPerMultiprocessor(&per_cu, (const void*)hymba_fwd, NWAVES * 64, LDS_BYTES) != hipSuccess || per_cu < 1) { fprintf(stderr, "kernel_launch: occupancy query says %d\n", per_cu); }
        (void)hipGetLastError();
        grid = cus;
    }
    if (grid < 0) return;
    if (hipMemsetAsync((char*)d_ws + WS_CTL, 0, CTL_ZERO_BYTES, stream) != hipSuccess) return;
    Args a{};
    for (int i = 0; i < 21; ++i) a.in[i] = d_in[i];
    a.out = (float*)d_out; a.ws = (unsigned char*)d_ws;
#if ONE_LAUNCH
    a.ph_lo = 0; a.ph_hi = NPHASE;
    hipLaunchKernelGGL(hymba_fwd, dim3(grid), dim3(NWAVES * 64), LDS_BYTES, stream, a);
#else
    for (int ph = 0; ph < NPHASE; ++ph) { a.ph_lo = ph; a.ph_hi = ph + 1; hipLaunchKernelGGL(hymba_fwd, dim3(grid), dim3(NWAVES * 64), LDS_BYTES, stream, a); }
#endif
}
```

```cpp
#include <hip/hip_runtime.h>
#include <cstdio>
#include <cstdint>
#include <cmath>
namespace pg8 {
#define PG8_LAS __attribute__((address_space(3)))
typedef unsigned short bf16_t;
typedef short bf16x8 __attribute__((ext_vector_type(8)));
typedef float f32x4 __attribute__((ext_vector_type(4)));
typedef unsigned u32x4 __attribute__((ext_vector_type(4)));
constexpr int BM = 256, BK = 64, HALF = 128, HTB = HALF * BK * 2  , STAGE_BYTES = 8 * HTB, NXCD = 8, WGM = 8;

__host__ __device__ __forceinline__ int lds_byte(int r, int c) { const int st = (r >> 4) * 2 + (c >> 5), rr = r & 15, cc = c & 31, ob = rr * 64 + cc * 2; return st * 1024 + (ob ^ (((ob >> 9) & 1) << 5)); }
__host__ __device__ __forceinline__ void stage_rc(int b, int& R, int& C) { const int st = b / 1024, sb = b % 1024, swz = sb ^ (((sb >> 9) & 1) << 5); R = (st >> 1) * 16 + swz / 64; C = (st & 1) * 32 + (swz % 64) / 2; }
__host__ __device__ __forceinline__ int perm32(int rho) { const int n = rho >> 4, i = rho & 15; return 8 * (i >> 2) + 4 * n + (i & 3); }

struct Unit { int pm, pn; };
struct Gemm { const bf16_t* A; const bf16_t* Bt; int M, N, K; };

struct StaticOrder {
    int nM, nN, nwg, G, c;
    __host__ __device__ void init(int M, int N, int G_, int c_) { nM = M / BM; nN = N / BM; nwg = nM * nN; G = G_; c = c_; }
    __host__ __device__ bool next(int i, Unit& u) const {
        const long L = (long)i * G + c; if (L >= nwg) return false;
        int wgid = (int)L; { const int q = nwg / NXCD, r = nwg % NXCD, xcd = wgid % NXCD, off = wgid / NXCD; wgid = (xcd < r ? xcd * (q + 1) : r * (q + 1) + (xcd - r) * q) + off; }
        const int nig = WGM * nN, gid = wgid / nig, fm = gid * WGM, gsz = (nM - fm) < WGM ? (nM - fm) : WGM;
        u.pm = fm + ((wgid % nig) % gsz); u.pn = (wgid % nig) / gsz; return true;
    }
    __device__ __forceinline__ size_t boff(const Unit&) const { return 0; }
    __device__ __forceinline__ void a_ready(const Unit&) const {}
    __device__ __forceinline__ void done(const Unit&) const {}
};

__device__ __forceinline__ unsigned cvt_pk_bf16(float lo, float hi) { unsigned r; asm volatile("v_cvt_pk_bf16_f32 %0, %1, %2" : "=v"(r) : "v"(lo), "v"(hi)); return r; }
typedef float f32x2 __attribute__((ext_vector_type(2)));
__device__ __forceinline__ f32x2 gelu_pk(f32x2 v) {
    const f32x2 av = __builtin_elementwise_abs(v), d = av * 0.2316418882f + 1.0f;
    f32x2 t; t.x = __builtin_amdgcn_rcpf(d.x); t.y = __builtin_amdgcn_rcpf(d.y);
    f32x2 q = t * 0.5307027145f + (-0.7265760135f); q = q * t + 0.7107068705f; q = q * t + (-0.142248368f); q = q * t + 0.127414796f; q = q * t;
    const f32x2 s = (v * v) * (-0.72134752044f);
    f32x2 e; e.x = __builtin_amdgcn_exp2f(s.x); e.y = __builtin_amdgcn_exp2f(s.y);
    const f32x2 m = v * (q * e), r = v - m;
    f32x2 o; o.x = v.x < 0.f ? m.x : r.x; o.y = v.y < 0.f ? m.y : r.y; return o;
}

template <int ACT  > struct EpiBf16 {
    static constexpr bool PERM = true, AFTER_DRAIN = false; static_assert(ACT == 0 || ACT == 1, "EpiBf16: ACT is 0 (none) or 1 (gelu_pk)");
    bf16_t* O; int ldc; const float* bias; int split_cols; size_t split_stride; float scale0;
    __device__ __forceinline__ void operator()(const f32x4 (&acc)[2][2][4][2], const Unit& u, int wr, int wc, int fr, int fq) const {
        const int row0 = u.pm * BM + wr * 64 + fr; int colt = u.pn * BM; bf16_t* base = O;
        float sc = 1.f; if (split_cols) { const int t = colt / split_cols; base += (size_t)t * split_stride; colt -= t * split_cols; if (t == 0) sc = scale0; }
        const int col0 = colt + wc * 32 + 8 * fq, bcol0 = u.pn * BM + wc * 32 + 8 * fq;
        f32x4 bv[2][2];
#pragma unroll
        for (int bj = 0; bj < 2; ++bj)
#pragma unroll
            for (int n = 0; n < 2; ++n) bv[bj][n] = bias ? *(const f32x4*)(bias + bcol0 + bj * HALF + 4 * n) : (f32x4){0.f, 0.f, 0.f, 0.f};
#pragma unroll
        for (int ai = 0; ai < 2; ++ai)
#pragma unroll
            for (int m = 0; m < 4; ++m) { bf16_t* rowp = base + (size_t)(row0 + ai * HALF + m * 16) * ldc + col0;
#pragma unroll
                for (int bj = 0; bj < 2; ++bj) { f32x4 v0 = acc[ai][bj][m][0] + bv[bj][0], v1 = acc[ai][bj][m][1] + bv[bj][1];
                    if (ACT == 1) { f32x2 a = gelu_pk((f32x2){v0[0], v0[1]}), b = gelu_pk((f32x2){v0[2], v0[3]}), c = gelu_pk((f32x2){v1[0], v1[1]}), d = gelu_pk((f32x2){v1[2], v1[3]});
                        v0 = (f32x4){a.x, a.y, b.x, b.y}; v1 = (f32x4){c.x, c.y, d.x, d.y}; }
                    v0 = v0 * sc; v1 = v1 * sc; u32x4 w; w.x = cvt_pk_bf16(v0[0], v0[1]); w.y = cvt_pk_bf16(v0[2], v0[3]); w.z = cvt_pk_bf16(v1[0], v1[1]); w.w = cvt_pk_bf16(v1[2], v1[3]);
                    *(u32x4*)(rowp + bj * HALF) = w; } }
    }
};
__device__ __forceinline__ float silu_f(float g) { return g * __builtin_amdgcn_rcpf(1.0f + __expf(-g)); }
struct EpiResF32 {
    static constexpr bool PERM = false, AFTER_DRAIN = false;
    const float* base; float* out; int ldc;
    __device__ __forceinline__ void operator()(const f32x4 (&acc)[2][2][4][2], const Unit& u, int wr, int wc, int fr, int fq) const {
        const int row0 = u.pm * BM + wr * 64 + fr, col0 = u.pn * BM + wc * 32 + 4 * fq;
#pragma unroll
        for (int ai = 0; ai < 2; ++ai)
#pragma unroll
            for (int m = 0; m < 4; ++m) { const size_t off = (size_t)(row0 + ai * HALF + m * 16) * ldc + col0;
#pragma unroll
                for (int bj = 0; bj < 2; ++bj)
#pragma unroll
                    for (int n = 0; n < 2; ++n) { const f32x4 b = *(const f32x4*)(base + off + bj * HALF + n * 16); *(f32x4*)(out + off + bj * HALF + n * 16) = b + acc[ai][bj][m][n]; }
                asm volatile("" ::: "memory"); }
    }
};
struct EpiSwiglu {
    static constexpr bool PERM = true, AFTER_DRAIN = false;
    bf16_t* O; int ldc;
    __device__ __forceinline__ void operator()(const f32x4 (&acc)[2][2][4][2], const Unit& u, int wr, int wc, int fr, int fq) const {
        const int row0 = u.pm * BM + wr * 64 + fr, col0 = u.pn * HALF + wc * 32 + 8 * fq;
#pragma unroll
        for (int ai = 0; ai < 2; ++ai)
#pragma unroll
            for (int m = 0; m < 4; ++m) { bf16_t* rowp = O + (size_t)(row0 + ai * HALF + m * 16) * ldc + col0;
                const f32x4 g0 = acc[ai][0][m][0], g1 = acc[ai][0][m][1], u0 = acc[ai][1][m][0], u1 = acc[ai][1][m][1];
                u32x4 w; w.x = cvt_pk_bf16(silu_f(g0[0]) * u0[0], silu_f(g0[1]) * u0[1]); w.y = cvt_pk_bf16(silu_f(g0[2]) * u0[2], silu_f(g0[3]) * u0[3]);
                w.z = cvt_pk_bf16(silu_f(g1[0]) * u1[0], silu_f(g1[1]) * u1[1]); w.w = cvt_pk_bf16(silu_f(g1[2]) * u1[2], silu_f(g1[3]) * u1[3]);
                *(u32x4*)rowp = w; }
    }
};
__device__ __forceinline__ float clamp8_pg(float x) { return __builtin_amdgcn_fmed3f(x, -448.f, 448.f); }
__device__ __forceinline__ unsigned fp8x4_pg(float a, float b, float c, float d) { int w = 0; w = __builtin_amdgcn_cvt_pk_fp8_f32(clamp8_pg(a), clamp8_pg(b), w, false); w = __builtin_amdgcn_cvt_pk_fp8_f32(clamp8_pg(c), clamp8_pg(d), w, true); return (unsigned)w; }
struct EpiSwiglu8 {
    static constexpr bool PERM = true, AFTER_DRAIN = false;
    unsigned char* O; int ldc; const float* rs;
    __device__ __forceinline__ void operator()(const f32x4 (&acc)[2][2][4][2], const Unit& u, int wr, int wc, int fr, int fq) const {
        const int row0 = u.pm * BM + wr * 64 + fr, col0 = u.pn * HALF + wc * 32 + 8 * fq;
        float rsv[2][4];
#pragma unroll
        for (int ai = 0; ai < 2; ++ai)
#pragma unroll
            for (int m = 0; m < 4; ++m) rsv[ai][m] = rs[row0 + ai * HALF + m * 16];
#pragma unroll
        for (int ai = 0; ai < 2; ++ai)
#pragma unroll
            for (int m = 0; m < 4; ++m) { unsigned char* rowp = O + (size_t)(row0 + ai * HALF + m * 16) * ldc + col0; const float rr_ = rsv[ai][m];
                const f32x4 g0 = acc[ai][0][m][0] * rr_, g1 = acc[ai][0][m][1] * rr_, u0 = acc[ai][1][m][0] * rr_, u1 = acc[ai][1][m][1] * rr_;
                const unsigned long long w = (unsigned long long)fp8x4_pg(4.f * silu_f(g0[0]) * u0[0], 4.f * silu_f(g0[1]) * u0[1], 4.f * silu_f(g0[2]) * u0[2], 4.f * silu_f(g0[3]) * u0[3])
                    | ((unsigned long long)fp8x4_pg(4.f * silu_f(g1[0]) * u1[0], 4.f * silu_f(g1[1]) * u1[1], 4.f * silu_f(g1[2]) * u1[2], 4.f * silu_f(g1[3]) * u1[3]) << 32);
                *(unsigned long long*)rowp = w; }
    }
};
struct EpiFp8 {
    static constexpr bool PERM = true, AFTER_DRAIN = false;
    unsigned char* O; int ldc; float s;
    __device__ __forceinline__ void operator()(const f32x4 (&acc)[2][2][4][2], const Unit& u, int wr, int wc, int fr, int fq) const {
        const int row0 = u.pm * BM + wr * 64 + fr, col0 = u.pn * BM + wc * 32 + 8 * fq;
#pragma unroll
        for (int ai = 0; ai < 2; ++ai)
#pragma unroll
            for (int m = 0; m < 4; ++m) { unsigned char* rowp = O + (size_t)(row0 + ai * HALF + m * 16) * ldc + col0;
#pragma unroll
                for (int bj = 0; bj < 2; ++bj) { const f32x4 v0 = acc[ai][bj][m][0] * s, v1 = acc[ai][bj][m][1] * s;
                    *(unsigned long long*)(rowp + bj * HALF) = (unsigned long long)fp8x4_pg(v0[0], v0[1], v0[2], v0[3]) | ((unsigned long long)fp8x4_pg(v1[0], v1[1], v1[2], v1[3]) << 32); } }
    }
};
struct OneUnit {
    StaticOrder base; int idx;
    __device__ __forceinline__ bool next(int i, Unit& u) const { return i == 0 && base.next(idx, u); }
    __device__ __forceinline__ size_t boff(const Unit&) const { return 0; }
    __device__ __forceinline__ void a_ready(const Unit&) const {}
    __device__ __forceinline__ void done(const Unit&) const {}
};
struct MoeOrder {
    const PG8_LAS int* tile_e; int ntiles, nN, G, c; size_t estride;
    __device__ __forceinline__ bool next(int i, Unit& u) const { const long L = (long)i * G + c; if (L >= (long)ntiles * nN) return false; u.pm = (int)(L / nN); u.pn = (int)(L % nN); return true; }
    __device__ __forceinline__ size_t boff(const Unit& u) const { return (size_t)__builtin_amdgcn_readfirstlane(tile_e[u.pm]) * estride; }
    __device__ __forceinline__ void a_ready(const Unit&) const {}
    __device__ __forceinline__ void done(const Unit&) const {}
};
template <class Epi, class Sched, bool ALIGN_EPI = false, bool SP2 = false>
__device__ __forceinline__ void gemm_phase(PG8_LAS unsigned char* lds, const Gemm g, const Sched& S, const Epi& E) {
    int tid_ = threadIdx.x; asm volatile("" : "+v"(tid_));
    const int tid = tid_, wid = __builtin_amdgcn_readfirstlane(tid >> 6), lane = tid & 63, wr = wid >> 2, wc = wid & 3, fr = lane & 15, fq = lane >> 4;
    const int K = g.K, nt = K / BK;
    unsigned voffA[2], voffB[2];
#pragma unroll
    for (int i = 0; i < 2; ++i) { int R, C; stage_rc(tid * 16 + i * 8192, R, C); const int Rb = Epi::PERM ? ((R & ~31) + perm32(R & 31)) : R;
        voffA[i] = (unsigned)(R * K + C) * 2u; voffB[i] = (unsigned)(Rb * K + C) * 2u; }
    const size_t kstep = (size_t)(BK * 2);
    const size_t hstep = (size_t)HALF * K * 2;
    const size_t tstep = 2 * hstep;
    const unsigned ldsw = (unsigned)wid * 1024u;
    const int aoff = lds_byte(wr * 64 + fr, fq * 8), boff = lds_byte(wc * 32 + fr, fq * 8);
#define PG8_SA(b, h) (((b) * 2 + (h)) * HTB)
#define PG8_SB(b, h) ((4 + (b) * 2 + (h)) * HTB)
#define PG8_STAGE(bufoff, gbase, voff) do { _Pragma("unroll") for (int _i = 0; _i < 2; ++_i) \
        __builtin_amdgcn_global_load_lds((const unsigned*)((const char*)(gbase) + (voff)[_i]), (PG8_LAS unsigned*)(lds + (bufoff) + ldsw + _i * 8192), 16, 0, 0); } while (0)
#define PG8_LDA(dst, b, h) do { _Pragma("unroll") for (int m = 0; m < 4; ++m) _Pragma("unroll") for (int k = 0; k < 2; ++k) dst[m][k] = *(const PG8_LAS bf16x8*)(lds + PG8_SA(b, h) + aoff + m * 2048 + k * 1024); } while (0)
#define PG8_LDB(dst, b, h) do { _Pragma("unroll") for (int n = 0; n < 2; ++n) _Pragma("unroll") for (int k = 0; k < 2; ++k) dst[n][k] = *(const PG8_LAS bf16x8*)(lds + PG8_SB(b, h) + boff + n * 2048 + k * 1024); } while (0)
#define PG8_MMA(ai, bj, At, Bt) do { __builtin_amdgcn_s_setprio(1); _Pragma("unroll") for (int m = 0; m < 4; ++m) _Pragma("unroll") for (int n = 0; n < 2; ++n) _Pragma("unroll") for (int k = 0; k < 2; ++k) \
        acc[ai][bj][m][n] = __builtin_amdgcn_mfma_f32_16x16x32_bf16(Bt[n][k], At[m][k], acc[ai][bj][m][n], 0, 0, 0); __builtin_amdgcn_s_setprio(0); } while (0)
#define PG8_WAIT_V(n) asm volatile("s_waitcnt vmcnt(" #n ")" ::: "memory")
#define PG8_WAIT_L(n) asm volatile("s_waitcnt lgkmcnt(" #n ")" ::: "memory")
#define PG8_BAR __builtin_amdgcn_s_barrier()
#define PG8_SCHED __builtin_amdgcn_sched_barrier(0)
    Unit cur, nxt; int ui = 0;
    if (!S.next(0, cur)) return;
    f32x4 acc[2][2][4][2];
#pragma unroll
    for (int a = 0; a < 2; ++a)
#pragma unroll
        for (int b = 0; b < 2; ++b)
#pragma unroll
            for (int m = 0; m < 4; ++m)
#pragma unroll
                for (int n = 0; n < 2; ++n) acc[a][b][m][n] = (f32x4){0.f, 0.f, 0.f, 0.f};
    bf16x8 At[4][2], B0[2][2], B1[2][2];
    const char* cA = (const char*)g.A + (size_t)cur.pm * tstep; const char* cB = (const char*)g.Bt + S.boff(cur) + (size_t)cur.pn * tstep;
    S.a_ready(cur);
    if constexpr (SP2) {
        PG8_STAGE(PG8_SB(0, 0), cB, voffB); PG8_STAGE(PG8_SB(0, 1), cB + hstep, voffB); PG8_STAGE(PG8_SA(0, 0), cA, voffA); PG8_STAGE(PG8_SA(0, 1), cA + hstep, voffA);
        if (wr == 1) PG8_BAR;
        PG8_WAIT_V(2); PG8_BAR;
        PG8_STAGE(PG8_SB(1, 0), cB + kstep, voffB); PG8_STAGE(PG8_SA(1, 0), cA + kstep, voffA); PG8_STAGE(PG8_SB(1, 1), cB + hstep + kstep, voffB);
        PG8_WAIT_V(6); PG8_BAR;
    } else {
        PG8_STAGE(PG8_SB(0, 0), cB, voffB); PG8_STAGE(PG8_SA(0, 0), cA, voffA); PG8_STAGE(PG8_SB(0, 1), cB + hstep, voffB); PG8_STAGE(PG8_SA(0, 1), cA + hstep, voffA);
        if (wr == 1) PG8_BAR;
        PG8_WAIT_V(4); PG8_BAR;
        PG8_STAGE(PG8_SB(1, 0), cB + kstep, voffB); PG8_STAGE(PG8_SA(1, 0), cA + kstep, voffA); PG8_STAGE(PG8_SB(1, 1), cB + hstep + kstep, voffB);
        PG8_WAIT_V(6); PG8_BAR;
    }
    for (;;) {
        const bool has_next = S.next(ui + 1, nxt);
        const char* nA = has_next ? (const char*)g.A + (size_t)nxt.pm * tstep : cA; const char* nB = has_next ? (const char*)g.Bt + S.boff(nxt) + (size_t)nxt.pn * tstep : cB;
        for (int t = 0; t < nt; t += 2) {
            const bool last = (t == nt - 2);
            const char* a1 = cA + (size_t)(t + 1) * kstep;
            const char* a2 = last ? nA : cA + (size_t)(t + 2) * kstep; const char* b2 = last ? nB : cB + (size_t)(t + 2) * kstep;
            const char* a3 = a2 + kstep; const char* b3 = b2 + kstep;
            if (last && has_next) S.a_ready(nxt);
            if constexpr (SP2) {
            PG8_LDB(B0, 0, 0); PG8_LDB(B1, 0, 1); PG8_SCHED; PG8_LDA(At, 0, 0); PG8_STAGE(PG8_SA(1, 1), a1 + hstep, voffA);
            PG8_WAIT_V(8); PG8_WAIT_L(0); PG8_BAR; PG8_MMA(0, 0, At, B0); PG8_MMA(0, 1, At, B1); PG8_BAR; PG8_SCHED;
            PG8_LDA(At, 0, 1); PG8_STAGE(PG8_SB(0, 0), b2, voffB); PG8_STAGE(PG8_SB(0, 1), b2 + hstep, voffB); PG8_STAGE(PG8_SA(0, 0), a2, voffA);
            PG8_WAIT_V(8); PG8_WAIT_L(0); PG8_BAR; PG8_MMA(1, 0, At, B0); PG8_MMA(1, 1, At, B1); PG8_BAR; PG8_SCHED;
            PG8_LDB(B0, 1, 0); PG8_LDB(B1, 1, 1); PG8_SCHED; PG8_LDA(At, 1, 0); PG8_STAGE(PG8_SA(0, 1), a2 + hstep, voffA);
            PG8_WAIT_V(8); PG8_WAIT_L(0); PG8_BAR; PG8_MMA(0, 0, At, B0); PG8_MMA(0, 1, At, B1); PG8_BAR; PG8_SCHED;
            PG8_LDA(At, 1, 1); PG8_STAGE(PG8_SB(1, 0), b3, voffB); PG8_STAGE(PG8_SB(1, 1), b3 + hstep, voffB); PG8_STAGE(PG8_SA(1, 0), a3, voffA);
            PG8_WAIT_V(8); PG8_WAIT_L(0); PG8_BAR; PG8_MMA(1, 0, At, B0); PG8_MMA(1, 1, At, B1); PG8_BAR; PG8_SCHED;
            } else {
            PG8_LDB(B0, 0, 0); PG8_SCHED; PG8_LDA(At, 0, 0); PG8_STAGE(PG8_SA(1, 1), a1 + hstep, voffA);
            PG8_WAIT_L(8); PG8_BAR; PG8_WAIT_L(0); PG8_MMA(0, 0, At, B0); PG8_BAR; PG8_SCHED;
            PG8_LDB(B1, 0, 1); PG8_STAGE(PG8_SB(0, 0), b2, voffB);
            PG8_BAR; PG8_WAIT_L(0); PG8_MMA(0, 1, At, B1); PG8_BAR;
            PG8_LDA(At, 0, 1); PG8_STAGE(PG8_SA(0, 0), a2, voffA);
            PG8_BAR; PG8_WAIT_L(0); PG8_MMA(1, 0, At, B0); PG8_BAR; PG8_SCHED;
            PG8_STAGE(PG8_SB(0, 1), b2 + hstep, voffB);
            PG8_WAIT_V(6); PG8_BAR; PG8_MMA(1, 1, At, B1); PG8_BAR;
            PG8_LDB(B0, 1, 0); PG8_SCHED; PG8_LDA(At, 1, 0); PG8_STAGE(PG8_SA(0, 1), a2 + hstep, voffA);
            PG8_WAIT_L(8); PG8_BAR; PG8_WAIT_L(0); PG8_MMA(0, 0, At, B0); PG8_BAR; PG8_SCHED;
            PG8_LDB(B1, 1, 1); PG8_STAGE(PG8_SB(1, 0), b3, voffB);
            PG8_BAR; PG8_WAIT_L(0); PG8_MMA(0, 1, At, B1); PG8_BAR;
            PG8_LDA(At, 1, 1); PG8_STAGE(PG8_SA(1, 0), a3, voffA);
            PG8_BAR; PG8_WAIT_L(0); PG8_MMA(1, 0, At, B0); PG8_BAR; PG8_SCHED;
            PG8_STAGE(PG8_SB(1, 1), b3 + hstep, voffB);
            PG8_WAIT_V(6); PG8_BAR; PG8_MMA(1, 1, At, B1); PG8_BAR;
            }
        }
        if constexpr (ALIGN_EPI) { if (wr == 0) PG8_BAR; }
        if constexpr (!Epi::AFTER_DRAIN) { E(acc, cur, wr, wc, fr, fq); S.done(cur); }
        if (!has_next) break;
#pragma unroll
        for (int a = 0; a < 2; ++a)
#pragma unroll
            for (int b = 0; b < 2; ++b)
#pragma unroll
                for (int m = 0; m < 4; ++m)
#pragma unroll
                    for (int n = 0; n < 2; ++n) acc[a][b][m][n] = (f32x4){0.f, 0.f, 0.f, 0.f};
        cur = nxt; cA = nA; cB = nB; ++ui;
        if constexpr (ALIGN_EPI) { if (wr == 1) PG8_BAR; }
    }
    PG8_WAIT_V(0);
    if constexpr (!ALIGN_EPI) { if (wr == 0) PG8_BAR; }
    PG8_BAR;
    if constexpr (Epi::AFTER_DRAIN) { E.fused(acc, cur, wr, wc, fr, fq, lds, wid, lane); S.done(cur); }
#undef PG8_SA
#undef PG8_SB
#undef PG8_STAGE
#undef PG8_LDA
#undef PG8_LDB
#undef PG8_MMA
#undef PG8_WAIT_V
#undef PG8_WAIT_L
#undef PG8_BAR
#undef PG8_SCHED
}
typedef int v4i_t __attribute__((ext_vector_type(4))); typedef int v8i_t __attribute__((ext_vector_type(8)));
template <class Epi, class Sched, bool ALIGN_EPI = false, bool SP2 = false, bool BT = false>
__device__ __forceinline__ void gemm_phase8(PG8_LAS unsigned char* lds, const Gemm g, const Sched& S, const Epi& E, const int sW, const int sA) {
    int tid_ = threadIdx.x; asm volatile("" : "+v"(tid_));
    const int tid = tid_, wid = __builtin_amdgcn_readfirstlane(tid >> 6), lane = tid & 63, wr = wid >> 2, wc = wid & 3, fr = lane & 15, fq = lane >> 4;
    const int K = g.K, nt = K / BK;
    unsigned voffA[2], voffB[2];
#pragma unroll
    for (int i = 0; i < 2; ++i) { int R, C; stage_rc(tid * 16 + i * 8192, R, C); const int Rb = Epi::PERM ? ((R & ~31) + perm32(R & 31)) : R;
        voffA[i] = (unsigned)(R * K + C) * 2u; voffB[i] = BT ? (unsigned)(tid * 16 + i * 8192) : (unsigned)(Rb * K + C) * 2u; }
    const size_t kstep = (size_t)(BK * 2);
    const size_t kstepB = BT ? (size_t)HTB : kstep;
    const size_t hstep = (size_t)HALF * K * 2;
    const size_t tstep = 2 * hstep;
    const unsigned ldsw = (unsigned)wid * 1024u;
    const int aoff = lds_byte(wr * 64 + fr, fq * 8), boff = lds_byte(wc * 32 + fr, fq * 8);
    constexpr int aoff1d = 1024, boff1d = 1024;
#define PG8_SA(b, h) (((b) * 2 + (h)) * HTB)
#define PG8_SB(b, h) ((4 + (b) * 2 + (h)) * HTB)
#define PG8_STAGE(bufoff, gbase, voff) do { _Pragma("unroll") for (int _i = 0; _i < 2; ++_i) \
        __builtin_amdgcn_global_load_lds((const unsigned*)((const char*)(gbase) + (voff)[_i]), (PG8_LAS unsigned*)(lds + (bufoff) + ldsw + _i * 8192), 16, 0, 0); } while (0)
#define PG8_LDA(dst, b, h) do { _Pragma("unroll") for (int m = 0; m < 4; ++m) { const v4i_t lo_ = *(const PG8_LAS v4i_t*)(lds + PG8_SA(b, h) + aoff + m * 2048), hi_ = *(const PG8_LAS v4i_t*)(lds + PG8_SA(b, h) + aoff + aoff1d + m * 2048); dst[m] = __builtin_shufflevector(lo_, hi_, 0, 1, 2, 3, 4, 5, 6, 7); } } while (0)
#define PG8_LDB(dst, b, h) do { _Pragma("unroll") for (int n = 0; n < 2; ++n) { const v4i_t lo_ = *(const PG8_LAS v4i_t*)(lds + PG8_SB(b, h) + boff + n * 2048), hi_ = *(const PG8_LAS v4i_t*)(lds + PG8_SB(b, h) + boff + boff1d + n * 2048); dst[n] = __builtin_shufflevector(lo_, hi_, 0, 1, 2, 3, 4, 5, 6, 7); } } while (0)
#define PG8_MMA(ai, bj, At, Bt) do { __builtin_amdgcn_s_setprio(1); _Pragma("unroll") for (int m = 0; m < 4; ++m) _Pragma("unroll") for (int n = 0; n < 2; ++n) \
        asm volatile("v_mfma_scale_f32_16x16x128_f8f6f4 %0, %1, %2, %0, %3, %4 op_sel_hi:[0,0,0]" : "+v"(acc[ai][bj][m][n]) : "v"(Bt[n]), "v"(At[m]), "v"(sW), "v"(sA)); __builtin_amdgcn_s_setprio(0); } while (0)
#define PG8_WAIT_V(n) asm volatile("s_waitcnt vmcnt(" #n ")" ::: "memory")
#define PG8_WAIT_L(n) asm volatile("s_waitcnt lgkmcnt(" #n ")" ::: "memory")
#define PG8_BAR __builtin_amdgcn_s_barrier()
#define PG8_SCHED __builtin_amdgcn_sched_barrier(0)
    Unit cur, nxt; int ui = 0;
    if (!S.next(0, cur)) return;
    f32x4 acc[2][2][4][2];
#pragma unroll
    for (int a = 0; a < 2; ++a)
#pragma unroll
        for (int b = 0; b < 2; ++b)
#pragma unroll
            for (int m = 0; m < 4; ++m)
#pragma unroll
                for (int n = 0; n < 2; ++n) acc[a][b][m][n] = (f32x4){0.f, 0.f, 0.f, 0.f};
    v8i_t At[4], B0[2], B1[2];
    const char* cA = (const char*)g.A + (size_t)cur.pm * tstep; const char* cB = (const char*)g.Bt + S.boff(cur) + (size_t)cur.pn * tstep;
    S.a_ready(cur);
    if constexpr (SP2) {
        PG8_STAGE(PG8_SB(0, 0), cB, voffB); PG8_STAGE(PG8_SB(0, 1), cB + hstep, voffB); PG8_STAGE(PG8_SA(0, 0), cA, voffA); PG8_STAGE(PG8_SA(0, 1), cA + hstep, voffA);
        if (wr == 1) PG8_BAR;
        PG8_WAIT_V(2); PG8_BAR;
        PG8_STAGE(PG8_SB(1, 0), cB + kstepB, voffB); PG8_STAGE(PG8_SA(1, 0), cA + kstep, voffA); PG8_STAGE(PG8_SB(1, 1), cB + hstep + kstepB, voffB);
        PG8_WAIT_V(6); PG8_BAR;
    } else {
        PG8_STAGE(PG8_SB(0, 0), cB, voffB); PG8_STAGE(PG8_SA(0, 0), cA, voffA); PG8_STAGE(PG8_SB(0, 1), cB + hstep, voffB); PG8_STAGE(PG8_SA(0, 1), cA + hstep, voffA);
        if (wr == 1) PG8_BAR;
        PG8_WAIT_V(4); PG8_BAR;
        PG8_STAGE(PG8_SB(1, 0), cB + kstepB, voffB); PG8_STAGE(PG8_SA(1, 0), cA + kstep, voffA); PG8_STAGE(PG8_SB(1, 1), cB + hstep + kstepB, voffB);
        PG8_WAIT_V(6); PG8_BAR;
    }
    for (;;) {
        const bool has_next = S.next(ui + 1, nxt);
        const char* nA = has_next ? (const char*)g.A + (size_t)nxt.pm * tstep : cA; const char* nB = has_next ? (const char*)g.Bt + S.boff(nxt) + (size_t)nxt.pn * tstep : cB;
#pragma unroll 1
        for (int t = 0; t < nt; t += 2) {
            const bool last = (t == nt - 2);
            const char* a1 = cA + (size_t)(t + 1) * kstep;
            const char* a2 = last ? nA : cA + (size_t)(t + 2) * kstep; const char* b2 = last ? nB : cB + (size_t)(t + 2) * kstepB;
            const char* a3 = a2 + kstep; const char* b3 = b2 + kstepB;
            if (last && has_next) S.a_ready(nxt);
            if constexpr (SP2) {
            PG8_LDB(B0, 0, 0); PG8_LDB(B1, 0, 1); PG8_SCHED; PG8_LDA(At, 0, 0); PG8_STAGE(PG8_SA(1, 1), a1 + hstep, voffA);
            PG8_WAIT_V(8); PG8_WAIT_L(0); PG8_BAR; PG8_MMA(0, 0, At, B0); PG8_MMA(0, 1, At, B1); PG8_BAR; PG8_SCHED;
            PG8_LDA(At, 0, 1); PG8_STAGE(PG8_SB(0, 0), b2, voffB); PG8_STAGE(PG8_SB(0, 1), b2 + hstep, voffB); PG8_STAGE(PG8_SA(0, 0), a2, voffA);
            PG8_WAIT_V(8); PG8_WAIT_L(0); PG8_BAR; PG8_MMA(1, 0, At, B0); PG8_MMA(1, 1, At, B1); PG8_BAR; PG8_SCHED;
            PG8_LDB(B0, 1, 0); PG8_LDB(B1, 1, 1); PG8_SCHED; PG8_LDA(At, 1, 0); PG8_STAGE(PG8_SA(0, 1), a2 + hstep, voffA);
            PG8_WAIT_V(8); PG8_WAIT_L(0); PG8_BAR; PG8_MMA(0, 0, At, B0); PG8_MMA(0, 1, At, B1); PG8_BAR; PG8_SCHED;
            PG8_LDA(At, 1, 1); PG8_STAGE(PG8_SB(1, 0), b3, voffB); PG8_STAGE(PG8_SB(1, 1), b3 + hstep, voffB); PG8_STAGE(PG8_SA(1, 0), a3, voffA);
            PG8_WAIT_V(8); PG8_WAIT_L(0); PG8_BAR; PG8_MMA(1, 0, At, B0); PG8_MMA(1, 1, At, B1); PG8_BAR; PG8_SCHED;
            } else {
            PG8_LDB(B0, 0, 0); PG8_SCHED; PG8_LDA(At, 0, 0); PG8_STAGE(PG8_SA(1, 1), a1 + hstep, voffA);
            PG8_WAIT_L(8); PG8_BAR; PG8_WAIT_L(0); PG8_MMA(0, 0, At, B0); PG8_BAR; PG8_SCHED;
            PG8_LDB(B1, 0, 1); PG8_STAGE(PG8_SB(0, 0), b2, voffB);
            PG8_BAR; PG8_WAIT_L(0); PG8_MMA(0, 1, At, B1); PG8_BAR;
            PG8_LDA(At, 0, 1); PG8_STAGE(PG8_SA(0, 0), a2, voffA);
            PG8_BAR; PG8_WAIT_L(0); PG8_MMA(1, 0, At, B0); PG8_BAR; PG8_SCHED;
            PG8_STAGE(PG8_SB(0, 1), b2 + hstep, voffB);
            PG8_WAIT_V(6); PG8_BAR; PG8_MMA(1, 1, At, B1); PG8_BAR;
            PG8_LDB(B0, 1, 0); PG8_SCHED; PG8_LDA(At, 1, 0); PG8_STAGE(PG8_SA(0, 1), a2 + hstep, voffA);
            PG8_WAIT_L(8); PG8_BAR; PG8_WAIT_L(0); PG8_MMA(0, 0, At, B0); PG8_BAR; PG8_SCHED;
            PG8_LDB(B1, 1, 1); PG8_STAGE(PG8_SB(1, 0), b3, voffB);
            PG8_BAR; PG8_WAIT_L(0); PG8_MMA(0, 1, At, B1); PG8_BAR;
            PG8_LDA(At, 1, 1); PG8_STAGE(PG8_SA(1, 0), a3, voffA);
            PG8_BAR; PG8_WAIT_L(0); PG8_MMA(1, 0, At, B0); PG8_BAR; PG8_SCHED;
            PG8_STAGE(PG8_SB(1, 1), b3 + hstep, voffB);
            PG8_WAIT_V(6); PG8_BAR; PG8_MMA(1, 1, At, B1); PG8_BAR;
            }
        }
        asm volatile("s_nop 15\n\ts_nop 15" ::: "memory");
        if constexpr (ALIGN_EPI) { if (wr == 0) PG8_BAR; }
        if constexpr (!Epi::AFTER_DRAIN) { E(acc, cur, wr, wc, fr, fq); S.done(cur); }
        if (!has_next) break;
#pragma unroll
        for (int a = 0; a < 2; ++a)
#pragma unroll
            for (int b = 0; b < 2; ++b)
#pragma unroll
                for (int m = 0; m < 4; ++m)
#pragma unroll
                    for (int n = 0; n < 2; ++n) acc[a][b][m][n] = (f32x4){0.f, 0.f, 0.f, 0.f};
        cur = nxt; cA = nA; cB = nB; ++ui;
        if constexpr (ALIGN_EPI) { if (wr == 1) PG8_BAR; }
    }
    PG8_WAIT_V(0);
    if constexpr (!ALIGN_EPI) { if (wr == 0) PG8_BAR; }
    PG8_BAR;
    if constexpr (Epi::AFTER_DRAIN) { E.fused(acc, cur, wr, wc, fr, fq, lds, wid, lane); S.done(cur); }
#undef PG8_SA
#undef PG8_SB
#undef PG8_STAGE
#undef PG8_LDA
#undef PG8_LDB
#undef PG8_MMA
#undef PG8_WAIT_V
#undef PG8_WAIT_L
#undef PG8_BAR
#undef PG8_SCHED
}
}
#define GAS __attribute__((address_space(1)))
#define LAS __attribute__((address_space(3)))
typedef unsigned short bf16;
typedef unsigned v4u __attribute__((ext_vector_type(4)));
typedef float f32x4 __attribute__((ext_vector_type(4)));
typedef short bf16x8 __attribute__((ext_vector_type(8)));
typedef GAS unsigned gu32;
typedef GAS unsigned long long gu64;
#define RLX_AGENT __ATOMIC_RELAXED, __HIP_MEMORY_SCOPE_AGENT
#define LDS_WAIT() asm volatile("s_waitcnt lgkmcnt(0)" ::: "memory")
#define VM_WAIT() asm volatile("s_waitcnt vmcnt(0)" ::: "memory")
__device__ __forceinline__ unsigned long long rt() { return __builtin_amdgcn_s_memrealtime(); }
__device__ __forceinline__ unsigned f2bf(float f) { unsigned u = __builtin_bit_cast(unsigned, f); return (u + 0x7fffu + ((u >> 16) & 1u)) >> 16; }
__device__ __forceinline__ unsigned pk2(float lo, float hi) { return f2bf(lo) | (f2bf(hi) << 16); }

#define XB_TMO      128
#define XB_XCNT(j)  (256  + 64 * (j))
#define XB_XSUB(j)  (1280 + 64 * (j))
#define XB_XGEN(j)  (2304 + 64 * (j))
#define XB_TOP      3328
#define XB_TOPGEN   3392
#define XCD_BAR_WORDS 3456
#define XB_SPIN_CAP (1u << 18)

__device__ __forceinline__ unsigned xb_ld(unsigned* p)              { return __hip_atomic_load(p, __ATOMIC_RELAXED, __HIP_MEMORY_SCOPE_AGENT); }
__device__ __forceinline__ unsigned xb_add(unsigned* p, unsigned v) { return __hip_atomic_fetch_add(p, v, __ATOMIC_RELAXED, __HIP_MEMORY_SCOPE_AGENT); }
__device__ __forceinline__ unsigned xb_xcc_id() { return (unsigned)__builtin_amdgcn_s_getreg((3 << 11) | 20) & 0xFu; }
#define XB_SPIN(cond, bar) do { unsigned _sp = 0; while (cond) { __builtin_amdgcn_s_sleep(1); \
    if ((++_sp & 255u) == 0u) { if (xb_ld(&(bar)[XB_TMO])) break; if (_sp > XB_SPIN_CAP) { atomicAdd(&(bar)[XB_TMO], 1u); break; } } } } while (0)

struct XcdBarrier {
    unsigned* bar; unsigned x;
    volatile LAS unsigned* st;
};

__device__ __forceinline__ XcdBarrier xcd_barrier_post(unsigned* bar, volatile LAS unsigned* st) {
    XcdBarrier b; b.bar = bar; b.x = xb_xcc_id(); b.st = st;
    if (threadIdx.x == 0) (void)xb_add(&bar[XB_XCNT(b.x)], 1u);
    return b;
}
__device__ __forceinline__ void xcd_barrier_complete(unsigned* bar, unsigned x, unsigned& nloc, unsigned& nx) {
    const unsigned G = gridDim.x * gridDim.y * gridDim.z;
    unsigned sum, cnt, mine, sp = 0u;
    for (;;) {
        sum = 0u; cnt = 0u; mine = 0u;
#pragma unroll
        for (unsigned j = 0; j < 16; ++j) { const unsigned c = xb_ld(&bar[XB_XCNT(j)]); sum += c; cnt += (c > 0u) ? 1u : 0u; mine = (j == x) ? c : mine; }
        if (sum == G) break;
        __builtin_amdgcn_s_sleep(1);
        if ((++sp & 255u) == 0u) { if (xb_ld(&bar[XB_TMO])) break; if (sp > XB_SPIN_CAP) { atomicAdd(&bar[XB_TMO], 1u); break; } }
    }
    nloc = mine > 0u ? mine : 1u; nx = cnt > 0u ? cnt : 1u;
}

__device__ __forceinline__ void xcd_barrier(const XcdBarrier& b) {
    asm volatile("s_waitcnt vmcnt(0)" ::: "memory");
    __syncthreads();
    if (threadIdx.x == 0) {
        unsigned* bar = b.bar;
        __builtin_amdgcn_s_waitcnt(0);
        unsigned nloc = b.st[0], nx = b.st[1];
        if (nloc == 0u) { xcd_barrier_complete(bar, b.x, nloc, nx); b.st[0] = nloc; b.st[1] = nx; }
        const unsigned old = xb_add(&bar[XB_XSUB(b.x)], 1u);
        const unsigned gen = old / nloc;
        if (old + 1u == (gen + 1u) * nloc) {
            __builtin_amdgcn_fence(__ATOMIC_RELEASE, "agent");
            asm volatile("s_waitcnt vmcnt(0)" ::: "memory");
            const unsigned og = xb_add(&bar[XB_TOP], 1u);
            const unsigned tg = og / nx;
            if (og + 1u == (tg + 1u) * nx) xb_add(&bar[XB_TOPGEN], 1u);
            else XB_SPIN(xb_ld(&bar[XB_TOPGEN]) == tg, bar);
            __builtin_amdgcn_fence(__ATOMIC_ACQUIRE, "agent");
            xb_add(&bar[XB_XGEN(b.x)], 1u);
            asm volatile("s_waitcnt vmcnt(0)" ::: "memory");
        } else {
            XB_SPIN(xb_ld(&bar[XB_XGEN(b.x)]) == gen, bar);
            __builtin_amdgcn_fence(__ATOMIC_ACQUIRE, "agent");
            asm volatile("s_waitcnt vmcnt(0)" ::: "memory");
        }
    }
    __syncthreads();
}

constexpr int NWAVES = 8;
#ifndef P1_INTERLEAVE
#define P1_INTERLEAVE 1
#endif
#ifndef P1_SHARE
#define P1_SHARE 67
#endif
#ifndef MOE_FP8
#define MOE_FP8 1
#endif
constexpr float W8_SCALE = 64.f;
#ifndef PROBE_LINEAR
#define PROBE_LINEAR 0
#endif
#ifndef C3_FLASH
#define C3_FLASH 1
#endif
#ifndef PROBE_DUP_VALU
#define PROBE_DUP_VALU 0
#endif
#ifndef MOE_CONV_IN_P1
#define MOE_CONV_IN_P1 0
#endif
#ifndef REP_MASK
#define REP_MASK 0
#endif
#define RPF(k) ((((REP_MASK) >> (k)) & 1) ? 2 : 1)
constexpr int T = 16384, D = 2048, NPROJ = 8192, NPROJ_SRC = 8224, DMIX = 3072, NCONV = 3072;
constexpr int NEXP = 64, DEXP = 1024;
constexpr float EPS = 1e-6f;
constexpr size_t MiB = 1u << 20;
constexpr size_t WS_CTL = 0, CTL_ZERO_BYTES = 1 * MiB;
constexpr size_t WS_DT = 2 * MiB;
constexpr size_t WS_EID = 4 * MiB;
constexpr size_t WS_GATE = WS_EID + 256 * 1024;
constexpr size_t WS_POS = WS_GATE + 256 * 1024;
constexpr size_t WS_DEST = WS_POS + 256 * 1024;
constexpr size_t WS_TILE = WS_DEST + 256 * 1024;
constexpr size_t WS_HIST = WS_TILE + 4096;
constexpr size_t WS_RSTD = WS_HIST + 65536;
constexpr size_t WS_WR = 6 * MiB;
constexpr size_t WS_W1T = 8 * MiB;
constexpr size_t WS_WOT = 42 * MiB;
constexpr size_t WS_WGU = 54 * MiB;
constexpr size_t WS_WD = 566 * MiB;
constexpr size_t WS_HN = 822 * MiB;
constexpr size_t WS_PROJ = 886 * MiB;
constexpr size_t WS_XBC = 1142 * MiB;
constexpr size_t WS_XBT = 1238 * MiB;
constexpr size_t WS_PREV = 1318 * MiB;
constexpr size_t WS_CS = 1350 * MiB;
constexpr size_t WS_DECAY = 1352 * MiB;
constexpr size_t WS_MIX = 1366 * MiB;
constexpr size_t WS_STATES = 1462 * MiB;
constexpr size_t WS_OP = 1526 * MiB;
constexpr size_t WS_ML = 1622 * MiB;
constexpr size_t WS_ROWRS = 7 * MiB;
constexpr size_t WS_WQ8 = 1628 * MiB;
constexpr size_t WS_HN8 = 1634 * MiB;
constexpr size_t WS_END = 1666 * MiB;
constexpr size_t WS_XG = 886 * MiB;
constexpr size_t WS_HID = 1078 * MiB;
constexpr size_t WS_Y = 1174 * MiB;
constexpr int CW_TMO = 0, CW_CODE = 1, CW_CNT = 64, CW_BAR = 4096;
constexpr int RING_OFF = 0, RING_BYTES = 131072;
constexpr int LDSCTL_OFF = RING_BYTES, MISC_OFF = LDSCTL_OFF + 320;
constexpr int TAB_OFF = RING_BYTES + 1024;
constexpr int SSP_OFF = RING_BYTES + 2048;
constexpr int CSL_OFF = SSP_OFF + 8192;
constexpr int LDS_BYTES = 163840;

struct Args { const void* in[21]; float* out; unsigned char* ws; int ph_lo, ph_hi; };
struct Frame { LAS unsigned char* lds; volatile LAS unsigned* MISC; gu32* ctl; int tid, lane, wave, vcu, G, gw, NGW; };

__device__ __forceinline__ float bflo(unsigned w) { return __uint_as_float(w << 16); }
__device__ __forceinline__ float bfhi(unsigned w) { return __uint_as_float(w & 0xffff0000u); }
__device__ __forceinline__ float bf2f(unsigned short b) { return __uint_as_float((unsigned)b << 16); }
typedef float f32x2_t __attribute__((ext_vector_type(2))); typedef __bf16 bf16x2_t __attribute__((ext_vector_type(2)));
__device__ __forceinline__ float clamp8(float x) { return __builtin_amdgcn_fmed3f(x, -448.f, 448.f); }
__device__ __forceinline__ unsigned fp8x4(float a, float b, float c, float d) { int w = 0; w = __builtin_amdgcn_cvt_pk_fp8_f32(clamp8(a), clamp8(b), w, false); w = __builtin_amdgcn_cvt_pk_fp8_f32(clamp8(c), clamp8(d), w, true); return (unsigned)w; }
__device__ __forceinline__ unsigned cvtpk(float lo, float hi) { f32x2_t v = {lo, hi}; bf16x2_t b = __builtin_convertvector(v, bf16x2_t); return __builtin_bit_cast(unsigned, b); }
__device__ __forceinline__ float wave_sum(float v) {
#pragma unroll
    for (int o = 1; o < 64; o <<= 1) v += __shfl_xor(v, o);
    return v;
}
__device__ __forceinline__ float wave_max(float v) {
#pragma unroll
    for (int o = 1; o < 64; o <<= 1) v = fmaxf(v, __shfl_xor(v, o));
    return v;
}
template <int CTRL> __device__ __forceinline__ float dppf(float x) { return __builtin_bit_cast(float, __builtin_amdgcn_mov_dpp(__builtin_bit_cast(int, x), CTRL, 0xf, 0xf, true)); }
__device__ __forceinline__ float row16_sum(float v) {
    v += dppf<0xB1>(v); v += dppf<0x4E>(v); v += dppf<0x141>(v); v += dppf<0x140>(v); return v;
}
__device__ __forceinline__ float silu(float g) { return g * __builtin_amdgcn_rcpf(1.0f + __expf(-g)); }

__device__ __forceinline__ void tr_item(const float* W, int N, int k0, int n0, bf16* WT, int Kd, int drow0, LAS float* scr, int lane) {
#pragma unroll 8
    for (int i = 0; i < 32; ++i) { const int kk = 2 * i + (lane >> 5); scr[kk * 33 + (lane & 31)] = W[(size_t)(k0 + kk) * N + n0 + (lane & 31)]; }
    LDS_WAIT(); asm volatile("" ::: "memory");
    const int c = lane & 7;
#pragma unroll
    for (int j = 0; j < 4; ++j) { const int n = (lane >> 3) + 8 * j; const LAS float* s = scr + (8 * c) * 33 + n;
        v4u o; o.x = pk2(s[0 * 33], s[1 * 33]); o.y = pk2(s[2 * 33], s[3 * 33]); o.z = pk2(s[4 * 33], s[5 * 33]); o.w = pk2(s[6 * 33], s[7 * 33]);
        *(GAS v4u*)(WT + (size_t)(drow0 + n) * Kd + k0 + 8 * c) = o; }
    LDS_WAIT(); asm volatile("" ::: "memory");
}
__device__ __forceinline__ void rms_row_to_bf16(const float* xrow, const float* w, bf16* orow, int lane, unsigned char* o8row = nullptr) {
    const GAS f32x4* xr = (const GAS f32x4*)xrow + lane; const GAS f32x4* wr = (const GAS f32x4*)w + lane;
    f32x4 v[8]; float s = 0.f;
#pragma unroll
    for (int j = 0; j < 8; ++j) { v[j] = xr[64 * j]; s += (v[j].x * v[j].x + v[j].y * v[j].y) + (v[j].z * v[j].z + v[j].w * v[j].w); }
    const float rstd = 1.0f / sqrtf(wave_sum(s) * (1.0f / D) + EPS);
    GAS unsigned long long* o8 = (GAS unsigned long long*)orow + lane;
#pragma unroll
    for (int j = 0; j < 8; ++j) { const f32x4 ww = wr[64 * j]; const f32x4 o = v[j] * rstd * ww;
        o8[64 * j] = (unsigned long long)pk2(o.x, o.y) | ((unsigned long long)pk2(o.z, o.w) << 32);
        if (o8row) *(unsigned*)(o8row + 4 * lane + 256 * j) = fp8x4(o.x, o.y, o.z, o.w); }
}
__device__ __forceinline__ void cv_load(f32x4 (&v)[16], const float* W, int N, int k0, int n0, int lane) {
    const int q = lane >> 4, c = lane & 15;
    const float* src = W + (size_t)(k0 + 8 * q) * N + n0 + 4 * c;
#pragma unroll
    for (int i = 0; i < 8; ++i) { v[i] = *(const f32x4*)(src + (size_t)i * N); v[8 + i] = *(const f32x4*)(src + (size_t)(32 + i) * N); }
}
__device__ __forceinline__ void cv_store(const f32x4 (&v)[16], int k0, bf16* WT, int Kd, int drow0, int lane) {
    const int q = lane >> 4, c = lane & 15;
    bf16* dst = WT + (size_t)(drow0 + 4 * c) * Kd + k0 + 8 * q;
#pragma unroll
    for (int j = 0; j < 4; ++j) {
        v4u o0, o1;
        o0.x = pk2(v[0][j], v[1][j]); o0.y = pk2(v[2][j], v[3][j]); o0.z = pk2(v[4][j], v[5][j]); o0.w = pk2(v[6][j], v[7][j]);
        o1.x = pk2(v[8][j], v[9][j]); o1.y = pk2(v[10][j], v[11][j]); o1.z = pk2(v[12][j], v[13][j]); o1.w = pk2(v[14][j], v[15][j]);
        *(v4u*)(dst + (size_t)j * Kd) = o0; *(v4u*)(dst + (size_t)j * Kd + 32) = o1; }
}
__device__ __forceinline__ void cv_item(const float* W, int N, int k0, int n0, bf16* WT, int Kd, int drow0, int lane) { f32x4 v[16]; cv_load(v, W, N, k0, n0, lane); cv_store(v, k0, WT, Kd, drow0, lane); }
struct MoeCvItem { const float* W; bf16* WT; int N, k0, n0, Kd, drow0; };
__device__ __forceinline__ MoeCvItem moe_cv_decode(const Args& a, int it) {
    constexpr int I_G = (D / 64) * (DEXP / 64), I_D = (DEXP / 64) * (D / 64), I_E = 2 * I_G + I_D;
    const int e = it / I_E; int rr = it % I_E; MoeCvItem m;
    if (rr < 2 * I_G) { const int up = rr >= I_G; rr -= up * I_G; const int kb = rr / (DEXP / 64), nb = rr % (DEXP / 64), n0 = nb * 64;
        m.W = (const float*)(up ? a.in[19] : a.in[18]) + (size_t)e * D * DEXP; m.N = DEXP; m.k0 = kb * 64; m.n0 = n0; m.WT = (bf16*)(a.ws + WS_WGU) + (size_t)e * 2048 * D; m.Kd = D; m.drow0 = (n0 >> 7) * 256 + (n0 & 127) + up * 128; }
    else { rr -= 2 * I_G; const int kb = rr / (D / 64), nb = rr % (D / 64);
        m.W = (const float*)a.in[20] + (size_t)e * DEXP * D; m.N = D; m.k0 = kb * 64; m.n0 = nb * 64; m.WT = (bf16*)(a.ws + WS_WD) + (size_t)e * D * DEXP; m.Kd = DEXP; m.drow0 = nb * 64; }
    return m;
}
__device__ __forceinline__ void moe_weight_items(const Args& a, int wi, int nw, int lane) {
    constexpr int NIT = NEXP * 3 * 512;
    int cur = wi; if (cur >= NIT) return;
    f32x4 va[16], vb[16];
    MoeCvItem mc = moe_cv_decode(a, cur); cv_load(va, mc.W, mc.N, mc.k0, mc.n0, lane);
    for (;;) {
        int nxt = cur + nw; MoeCvItem mn = mc;
        if (nxt < NIT) { mn = moe_cv_decode(a, nxt); cv_load(vb, mn.W, mn.N, mn.k0, mn.n0, lane); }
        cv_store(va, mc.k0, mc.WT, mc.Kd, mc.drow0, lane);
        if (nxt >= NIT) break;
        cur = nxt; mc = mn; nxt = cur + nw;
        if (nxt < NIT) { mn = moe_cv_decode(a, nxt); cv_load(va, mn.W, mn.N, mn.k0, mn.n0, lane); }
        cv_store(vb, mc.k0, mc.WT, mc.Kd, mc.drow0, lane);
        if (nxt >= NIT) break;
        cur = nxt; mc = mn;
    }
}
#if MOE_FP8
struct MoeTile { const float* W; unsigned char* WT; int N, k0, n0, Kd, up, glu, d0; };
constexpr int NT_QKV = 8 * 12;
__device__ __forceinline__ MoeTile moe_tile_decode(const Args& a, int it) {
    MoeTile m;
    if (it < NT_QKV) { m.W = (const float*)a.in[3]; m.N = NPROJ_SRC; m.k0 = (it / 12) * 256; m.n0 = 5152 + (it % 12) * 256; m.WT = (unsigned char*)(a.ws + WS_WQ8); m.Kd = D; m.up = 0; m.glu = 0; m.d0 = (it % 12) * 256; return m; }
    it -= NT_QKV;
    const int e = it / 96; int rr = it % 96;
    if (rr < 64) { const int up = rr >= 32; rr -= up * 32; m.W = (const float*)(up ? a.in[19] : a.in[18]) + (size_t)e * D * DEXP; m.N = DEXP; m.k0 = (rr >> 2) * 256; m.n0 = (rr & 3) * 256;
        m.WT = (unsigned char*)(a.ws + WS_WGU) + (size_t)e * 2048 * D; m.Kd = D; m.up = up; m.glu = 1; m.d0 = (m.n0 >> 7) * 256 + up * 128; }
    else { rr -= 64; m.W = (const float*)a.in[20] + (size_t)e * DEXP * D; m.N = D; m.k0 = (rr >> 3) * 256; m.n0 = (rr & 7) * 256; m.WT = (unsigned char*)(a.ws + WS_WD) + (size_t)e * D * DEXP; m.Kd = DEXP; m.up = 0; m.glu = 0; m.d0 = m.n0; }
    return m;
}
__device__ __forceinline__ void moe_tile_load(f32x4 (&v)[16], const MoeTile& m, int half, int wave, int lane) {
    const float* src = m.W + (size_t)(m.k0 + 128 * half + 16 * wave) * m.N + m.n0 + 4 * lane;
#pragma unroll
    for (int i = 0; i < 16; ++i) v[i] = *(const f32x4*)(src + (size_t)i * m.N);
}
__device__ __forceinline__ void moe_tile_park(const f32x4 (&v)[16], LAS unsigned char* tl, int half, int wave, int lane) {
#pragma unroll
    for (int j = 0; j < 4; ++j) { v4u o;
        o.x = fp8x4(v[0][j] * W8_SCALE, v[1][j] * W8_SCALE, v[2][j] * W8_SCALE, v[3][j] * W8_SCALE); o.y = fp8x4(v[4][j] * W8_SCALE, v[5][j] * W8_SCALE, v[6][j] * W8_SCALE, v[7][j] * W8_SCALE);
        o.z = fp8x4(v[8][j] * W8_SCALE, v[9][j] * W8_SCALE, v[10][j] * W8_SCALE, v[11][j] * W8_SCALE); o.w = fp8x4(v[12][j] * W8_SCALE, v[13][j] * W8_SCALE, v[14][j] * W8_SCALE, v[15][j] * W8_SCALE);
        *(LAS v4u*)(tl + (4 * lane + j) * 256 + (((8 * half + wave) ^ ((lane + 4 * j) & 15)) << 4)) = o; }
}
constexpr int NT_ALL = NT_QKV + NEXP * 96;
__device__ __forceinline__ void moe_weight_tiles(const Args& a, Frame& F, int first, const int NT) {
    int cur = first; if (cur >= NT) return;
    int lane_ = F.lane, tid_ = F.tid; asm volatile("" : "+v"(lane_), "+v"(tid_));
    f32x4 va[16], vb[16];
    MoeTile mc = moe_tile_decode(a, cur); moe_tile_load(va, mc, 0, F.wave, lane_);
    int buf = 0;
    for (;;) {
        LAS unsigned char* tl = F.lds + RING_OFF + buf * 65536;
        moe_tile_load(vb, mc, 1, F.wave, lane_);
        moe_tile_park(va, tl, 0, F.wave, lane_);
        const int nxt = cur + F.G; MoeTile mn = mc;
        if (nxt < NT) { mn = moe_tile_decode(a, nxt); moe_tile_load(va, mn, 0, F.wave, lane_); }
        moe_tile_park(vb, tl, 1, F.wave, lane_);
        __syncthreads();
#pragma unroll
        for (int i = 0; i < 8; ++i) {
            const int P = tid_ + 512 * i, q = P >> 10, p = P & 1023, gq = q >> 1, ktl = q & 1;
            const int st = p >> 6, sb = (p & 63) * 16, swz = sb ^ (((sb >> 9) & 1) << 5), Rimg = (st >> 1) * 16 + (swz >> 6), kbyte = (st & 1) * 64 + (swz & 63);
            const int r128 = (Rimg & ~31) + pg8::perm32(Rimg & 31), row = gq * 128 + r128, ch = 8 * ktl + (kbyte >> 4);
            const int drow = mc.d0 + gq * (mc.glu ? 256 : 128);
            *(v4u*)(mc.WT + (size_t)drow * mc.Kd + (size_t)((mc.k0 >> 7) + ktl) * 16384 + p * 16) = *(const LAS v4u*)(tl + row * 256 + ((ch ^ (((row >> 2) + 4 * (row & 3)) & 15)) << 4)); }
        if (nxt >= NT) break;
        cur = nxt; mc = mn; buf ^= 1;
    }
    __syncthreads();
}
#else
struct MoeTile { const float* W; bf16* WT; int N, k0, n0, Kd, up, glu; };
__device__ __forceinline__ MoeTile moe_tile_decode(const Args& a, int it) {
    const int e = it / 192; int rr = it % 192; MoeTile m;
    if (rr < 128) { const int up = rr >= 64; rr -= up * 64; m.W = (const float*)(up ? a.in[19] : a.in[18]) + (size_t)e * D * DEXP; m.N = DEXP; m.k0 = (rr >> 2) * 128; m.n0 = (rr & 3) * 256;
        m.WT = (bf16*)(a.ws + WS_WGU) + (size_t)e * 2048 * D; m.Kd = D; m.up = up; m.glu = 1; }
    else { rr -= 128; m.W = (const float*)a.in[20] + (size_t)e * DEXP * D; m.N = D; m.k0 = (rr >> 3) * 128; m.n0 = (rr & 7) * 256; m.WT = (bf16*)(a.ws + WS_WD) + (size_t)e * D * DEXP; m.Kd = DEXP; m.up = 0; m.glu = 0; }
    return m;
}
__device__ __forceinline__ void moe_tile_load(f32x4 (&v)[16], const MoeTile& m, int wave, int lane) {
    const float* src = m.W + (size_t)(m.k0 + 16 * wave) * m.N + m.n0 + 4 * lane;
#pragma unroll
    for (int i = 0; i < 16; ++i) v[i] = *(const f32x4*)(src + (size_t)i * m.N);
}
__device__ __forceinline__ void moe_weight_tiles(const Args& a, Frame& F) {
    constexpr int NT = NEXP * 192;
    int cur = (int)blockIdx.x; if (cur >= NT) return;
    f32x4 va[16], vb[16];
    MoeTile mc = moe_tile_decode(a, cur); moe_tile_load(va, mc, F.wave, F.lane);
    int buf = 0;
#define MOE_TILE_STEP(VCUR, VNXT) { \
        const int nxt = cur + F.G; MoeTile mn = mc; \
        if (nxt < NT) { mn = moe_tile_decode(a, nxt); moe_tile_load(VNXT, mn, F.wave, F.lane); } \
        LAS unsigned char* tl = F.lds + RING_OFF + buf * 65536; \
        _Pragma("unroll") for (int j = 0; j < 4; ++j) { v4u o0, o1; \
            o0.x = pk2(VCUR[0][j], VCUR[1][j]); o0.y = pk2(VCUR[2][j], VCUR[3][j]); o0.z = pk2(VCUR[4][j], VCUR[5][j]); o0.w = pk2(VCUR[6][j], VCUR[7][j]); \
            o1.x = pk2(VCUR[8][j], VCUR[9][j]); o1.y = pk2(VCUR[10][j], VCUR[11][j]); o1.z = pk2(VCUR[12][j], VCUR[13][j]); o1.w = pk2(VCUR[14][j], VCUR[15][j]); \
            LAS unsigned char* p = tl + (4 * F.lane + j) * 256; *(LAS v4u*)(p + (((2 * F.wave) ^ (F.lane & 15)) << 4)) = o0; *(LAS v4u*)(p + (((2 * F.wave + 1) ^ (F.lane & 15)) << 4)) = o1; } \
        __syncthreads(); \
        _Pragma("unroll") for (int i = 0; i < 8; ++i) { const int piece = F.tid + 512 * i, row = piece >> 4, ch = piece & 15, n = mc.n0 + row; \
            const int drow = mc.glu ? ((n >> 7) * 256 + (n & 127) + mc.up * 128) : n; \
            *(v4u*)(mc.WT + (size_t)drow * mc.Kd + mc.k0 + 8 * ch) = *(const LAS v4u*)(tl + row * 256 + ((ch ^ ((row >> 2) & 15)) << 4)); } \
        if (nxt >= NT) break; \
        cur = nxt; mc = mn; buf ^= 1; }
    for (;;) { MOE_TILE_STEP(va, vb) MOE_TILE_STEP(vb, va) }
#undef MOE_TILE_STEP
    __syncthreads();
}
#endif
__device__ __forceinline__ void p0_prologue(const Args& a, Frame& F) {
    LAS float* scr = (LAS float*)(F.lds + RING_OFF + F.wave * 16384);
    const float* w_in = (const float*)a.in[3]; const float* w_out = (const float*)a.in[12];
    bf16* W1T = (bf16*)(a.ws + WS_W1T); bf16* WOT = (bf16*)(a.ws + WS_WOT);
    constexpr int NB_IN = NPROJ_SRC / 32;
    constexpr int I_IN = (D / 64) * NB_IN, I_OUT = (DMIX / 64) * (D / 64);
    for (int it = F.gw; it < I_IN + I_OUT; it += F.NGW) {
        if (it < I_IN) { const int kb = it / NB_IN, nb = it % NB_IN, n0 = nb * 32;
            if (MOE_FP8 && n0 >= 5152) continue;
            const int drow = n0 < 5120 ? n0 : (n0 < 5152 ? 8192 + (n0 - 5120) : n0 - 32);
            tr_item(w_in, NPROJ_SRC, kb * 64, n0, W1T, D, drow, scr, F.lane); }
        else { const int r = it - I_IN, kb = r / (D / 64), nb = r % (D / 64); cv_item(w_out, D, kb * 64, nb * 64, WOT, DMIX, nb * 64, F.lane); }
    }
    { const float* Wgr = (const float*)a.in[14]; const float* Wer = (const float*)a.in[16]; bf16* WRH = (bf16*)(a.ws + WS_WR); bf16* WRL = WRH + 80 * D;
      for (int idx = F.gw * 64 + F.lane; idx < 80 * D; idx += F.NGW * 64) { const int c = idx / D, k = idx % D; float v = 0.f;
          if (c < 8) v = Wgr[(size_t)k * 8 + c]; else if (c < 72) { const int g = (c - 8) >> 3, e = (c - 8) & 7; v = Wer[((size_t)g * D + k) * 8 + e]; }
          const unsigned hi = f2bf(v); const float rem = v - __uint_as_float(hi << 16);
          const int di = ((((c >> 4) * 8 + (k >> 8)) * 8 + ((k >> 5) & 7)) * 64 + ((c & 15) + 16 * ((k >> 3) & 3))) * 8 + (k & 7);
          WRH[di] = (bf16)hi; WRL[di] = (bf16)f2bf(rem); } }
    const float* x = (const float*)a.in[0]; const float* n1w = (const float*)a.in[2]; bf16* HN = (bf16*)(a.ws + WS_HN);
    {
        const int lane = F.lane; const GAS f32x4* wr = (const GAS f32x4*)n1w + lane;
        int m = F.gw; f32x4 v[8];
        if (m < T) { const GAS f32x4* xr = (const GAS f32x4*)(x + (size_t)m * D) + lane;
#pragma unroll
            for (int j = 0; j < 8; ++j) v[j] = xr[64 * j]; }
#pragma unroll 1
        while (m < T) {
            const int mn = m + F.NGW; f32x4 vn[8];
            { const GAS f32x4* xr = (const GAS f32x4*)(x + (size_t)(mn < T ? mn : m) * D) + lane;
#pragma unroll
              for (int j = 0; j < 8; ++j) vn[j] = xr[64 * j]; }
            float s = 0.f;
#pragma unroll
            for (int j = 0; j < 8; ++j) s += (v[j].x * v[j].x + v[j].y * v[j].y) + (v[j].z * v[j].z + v[j].w * v[j].w);
            const float rstd = 1.0f / sqrtf(wave_sum(s) * (1.0f / D) + EPS);
            GAS unsigned long long* o8 = (GAS unsigned long long*)(HN + (size_t)m * D) + lane; unsigned char* o8row = (unsigned char*)(a.ws + WS_HN8) + (size_t)m * D;
#pragma unroll
            for (int j = 0; j < 8; ++j) { const f32x4 ww = wr[64 * j]; const f32x4 o = v[j] * rstd * ww;
                o8[64 * j] = (unsigned long long)pk2(o.x, o.y) | ((unsigned long long)pk2(o.z, o.w) << 32);
                if (MOE_FP8) *(unsigned*)(o8row + 4 * lane + 256 * j) = fp8x4(o.x, o.y, o.z, o.w); }
#pragma unroll
            for (int j = 0; j < 8; ++j) v[j] = vn[j];
            m = mn; }
    }
    __syncthreads();
#if MOE_FP8
    moe_weight_tiles(a, F, (int)blockIdx.x, P1_INTERLEAVE ? NT_QKV : NT_ALL);
#else
    moe_weight_tiles(a, F);
#endif
}

__device__ __forceinline__ void p2_postproj(const Args& a, Frame& F) {
    bf16* PROJ = (bf16*)(a.ws + WS_PROJ); const bf16* HN = (const bf16*)(a.ws + WS_HN); const bf16* WDTT = (const bf16*)(a.ws + WS_W1T) + (size_t)8192 * D;
    float* DT = (float*)(a.ws + WS_DT); bf16* XBC = (bf16*)(a.ws + WS_XBC);
    const int lane = F.lane;
    { const float* dt_bias = (const float*)a.in[6];
      for (int itt = F.gw; itt < (T / 8) * RPF(23); itt += F.NGW) { const int it = (itt & (T / 8 - 1)) >> 1, ct = itt & 1;
        const int t0 = it * 16; f32x4 acc0 = {0.f, 0.f, 0.f, 0.f}, acc1 = {0.f, 0.f, 0.f, 0.f};
        const bf16* ap = HN + (size_t)(t0 + (lane & 15)) * D + 8 * (lane >> 4);
        const bf16* bp0 = WDTT + (size_t)(ct * 16 + (lane & 15)) * D + 8 * (lane >> 4);
#pragma unroll 4
        for (int s = 0; s < D / 64; ++s) { const bf16x8 av0 = *(const bf16x8*)(ap + 64 * s), b0 = *(const bf16x8*)(bp0 + 64 * s), av1 = *(const bf16x8*)(ap + 64 * s + 32), b1 = *(const bf16x8*)(bp0 + 64 * s + 32);
            acc0 = __builtin_amdgcn_mfma_f32_16x16x32_bf16(av0, b0, acc0, 0, 0, 0); acc1 = __builtin_amdgcn_mfma_f32_16x16x32_bf16(av1, b1, acc1, 0, 0, 0); }
        const int hd0 = ct * 16 + (lane & 15); const float bi0 = dt_bias[hd0]; f32x4 d0;
#pragma unroll
        for (int r = 0; r < 4; ++r) { float v0 = acc0[r] + acc1[r] + bi0; v0 = v0 > 20.f ? v0 : log1pf(expf(v0)); d0[r] = v0; }
        *(f32x4*)(DT + (size_t)hd0 * T + t0 + (lane >> 4) * 4) = d0;
      } }
    { const float* cw = (const float*)a.in[4]; const float* cb = (const float*)a.in[5]; bf16* XBT = (bf16*)(a.ws + WS_XBT);
      for (int itt = F.gw; itt < (T / 64) * (NCONV / 128) * RPF(2); itt += F.NGW) { const int it = itt % ((T / 64) * (NCONV / 128));
        const int cbk = it / (T / 64), tb = it % (T / 64), c = cbk * 128 + 2 * lane, t0 = tb * 64;
        const float w00 = cw[c], w01 = cw[c + 1], w10 = cw[NCONV + c], w11 = cw[NCONV + c + 1], w20 = cw[2 * NCONV + c], w21 = cw[2 * NCONV + c + 1], w30 = cw[3 * NCONV + c], w31 = cw[3 * NCONV + c + 1];
        const float b0 = cb[c], b1 = cb[c + 1];
        const bf16* src = PROJ + 2048 + c;
        float r00 = 0.f, r01 = 0.f, r10 = 0.f, r11 = 0.f, r20 = 0.f, r21 = 0.f;
        if (t0 > 0) { const unsigned u0 = *(const unsigned*)(src + (size_t)(t0 - 3) * NPROJ), u1 = *(const unsigned*)(src + (size_t)(t0 - 2) * NPROJ), u2 = *(const unsigned*)(src + (size_t)(t0 - 1) * NPROJ);
            r00 = bflo(u0); r01 = bfhi(u0); r10 = bflo(u1); r11 = bfhi(u1); r20 = bflo(u2); r21 = bfhi(u2); }
        unsigned xt0[32], xt1[32];
#pragma unroll
        for (int tt = 0; tt < 32; ++tt) {
            const unsigned ua = *(const unsigned*)(src + (size_t)(t0 + 2 * tt) * NPROJ), ub = *(const unsigned*)(src + (size_t)(t0 + 2 * tt + 1) * NPROJ);
            const float a0 = bflo(ua), a1 = bfhi(ua), c0 = bflo(ub), c1 = bfhi(ub);
            const float ya0 = silu(b0 + w00 * r00 + w10 * r10 + w20 * r20 + w30 * a0), ya1 = silu(b1 + w01 * r01 + w11 * r11 + w21 * r21 + w31 * a1);
            const float yb0 = silu(b0 + w00 * r10 + w10 * r20 + w20 * a0 + w30 * c0), yb1 = silu(b1 + w01 * r11 + w11 * r21 + w21 * a1 + w31 * c1);
            *(unsigned*)(XBC + (size_t)(t0 + 2 * tt) * NCONV + c) = pk2(ya0, ya1); *(unsigned*)(XBC + (size_t)(t0 + 2 * tt + 1) * NCONV + c) = pk2(yb0, yb1);
            xt0[tt] = pk2(ya0, yb0); xt1[tt] = pk2(ya1, yb1);
            r00 = r20; r01 = r21; r10 = a0; r11 = a1; r20 = c0; r21 = c1; }
        if (cbk < 20) {
            LAS unsigned char* tt_ = F.lds + RING_OFF + F.wave * 16384;
#pragma unroll
            for (int k = 0; k < 8; ++k) { v4u u; u.x = xt0[4 * k]; u.y = xt0[4 * k + 1]; u.z = xt0[4 * k + 2]; u.w = xt0[4 * k + 3]; *(LAS v4u*)(tt_ + (2 * lane) * 128 + ((k ^ (lane & 7)) << 4)) = u;
                v4u w; w.x = xt1[4 * k]; w.y = xt1[4 * k + 1]; w.z = xt1[4 * k + 2]; w.w = xt1[4 * k + 3]; *(LAS v4u*)(tt_ + (2 * lane + 1) * 128 + ((k ^ (lane & 7)) << 4)) = w; }
            LDS_WAIT(); asm volatile("" ::: "memory");
#pragma unroll
            for (int i = 0; i < 16; ++i) { const int rb = i >> 2, ksl = i & 3, row = rb * 32 + (lane & 31), pc = 2 * ksl + (lane >> 5);
                const size_t fo = ((size_t)((cbk * 4 + rb) * 64 + (t0 >> 8)) * 16 + ((t0 & 255) >> 4) + ksl) * 1024 + lane * 16;
                *(v4u*)((unsigned char*)XBT + fo) = *(const LAS v4u*)(tt_ + row * 128 + ((pc ^ ((row >> 1) & 7)) << 4)); }
            LDS_WAIT(); asm volatile("" ::: "memory"); }
      } }
    { const int* positions = (const int*)a.in[1]; const float* qnw = (const float*)a.in[10]; const float* knw = (const float*)a.in[11];
      const int hv = lane >> 1, half = lane & 1; const float* nw = (hv < 16 ? qnw : knw) + half * 32;
      float nwv[32];
#pragma unroll
      for (int i = 0; i < 32; ++i) nwv[i] = nw[i];
      const float invf[8] = {1.0f, 0.19392274474868576f, 0.03760603093086393f, 0.007292664737217109f, 0.001414213562373095f, 0.0002742481756762073f, 5.318295896944988e-05f, 1.031338537721246e-05f};
      for (int t = F.gw; t < T; t += F.NGW) {
        v4u* p = (v4u*)(PROJ + (size_t)t * NPROJ + 5120 + lane * 32);
        float v[32]; float ss = 0.f;
#pragma unroll
        for (int j = 0; j < 4; ++j) { const v4u u = p[j];
            v[8 * j + 0] = bflo(u.x); v[8 * j + 1] = bfhi(u.x); v[8 * j + 2] = bflo(u.y); v[8 * j + 3] = bfhi(u.y); v[8 * j + 4] = bflo(u.z); v[8 * j + 5] = bfhi(u.z); v[8 * j + 6] = bflo(u.w); v[8 * j + 7] = bfhi(u.w); }
#pragma unroll
        for (int i = 0; i < 32; ++i) ss += v[i] * v[i];
        ss += dppf<0xB1>(ss);
        const float rstd = 1.0f / sqrtf(ss * (1.0f / 64.0f) + EPS);
#pragma unroll
        for (int i = 0; i < 32; ++i) v[i] = v[i] * rstd * nwv[i];
        if (half == 0) { const float pos = (float)positions[t];
#pragma unroll
            for (int i = 0; i < 8; ++i) { float sn, cs;
                { const float ch[8] = {0.15915493667125702f, 0.030863763764500618f, 0.005985185503959656f, 0.0011606636689975858f, 0.0002250790857942775f, 4.3647953134495765e-05f, 8.464330676360987e-06f, 1.6414262518082978e-06f};
                  const float cl[8] = {6.4206382432985265e-09f, -3.597993847304082e-10f, 2.0875405570830452e-10f, -2.775752544481591e-11f, -6.755001072389355e-12f, -3.4169287408195026e-13f, 1.3188041424975344e-13f, 1.0986736456860494e-14f};
                  const float p = pos * ch[i], e = __builtin_fmaf(pos, ch[i], -p); const float rev = __builtin_amdgcn_fractf(p) + (e + pos * cl[i]);
                  sn = __builtin_amdgcn_sinf(rev); cs = __builtin_amdgcn_cosf(rev); }
                const float x1 = v[i], x2 = v[8 + i]; v[i] = x1 * cs - x2 * sn; v[8 + i] = x2 * cs + x1 * sn; } }
        const float sc = hv < 16 ? 0.125f * 1.4426950408889634f : 1.0f;
#pragma unroll
        for (int j = 0; j < 4; ++j) { v4u u; u.x = pk2(v[8 * j + 0] * sc, v[8 * j + 1] * sc); u.y = pk2(v[8 * j + 2] * sc, v[8 * j + 3] * sc); u.z = pk2(v[8 * j + 4] * sc, v[8 * j + 5] * sc); u.w = pk2(v[8 * j + 6] * sc, v[8 * j + 7] * sc); p[j] = u; }
      } }
}

typedef float f32x16 __attribute__((ext_vector_type(16)));
__device__ __forceinline__ bf16x8 scale8(const bf16x8 a, const f32x4 w0, const f32x4 w1) {
    const v4u u = __builtin_bit_cast(v4u, a); v4u o;
    o.x = cvtpk(bflo(u.x) * w0.x, bfhi(u.x) * w0.y); o.y = cvtpk(bflo(u.y) * w0.z, bfhi(u.y) * w0.w);
    o.z = cvtpk(bflo(u.z) * w1.x, bfhi(u.z) * w1.y); o.w = cvtpk(bflo(u.w) * w1.z, bfhi(u.w) * w1.w);
    return __builtin_bit_cast(bf16x8, o);
}
__device__ __forceinline__ void ssd_c1(const Args& a, Frame& F) {
    const bf16* XBT = (const bf16*)(a.ws + WS_XBT); const float* DT = (const float*)(a.ws + WS_DT); const float* A_log = (const float*)a.in[7];
    float* CS = (float*)(a.ws + WS_CS); float* DECAY = (float*)(a.ws + WS_DECAY); float* STATES = (float*)(a.ws + WS_STATES);
    LAS float* wl = (LAS float*)(F.lds + RING_OFF + F.wave * 2048);
    const int lane = F.lane, r = lane & 31, hh = lane >> 5;
    for (int uu = (int)blockIdx.x; uu < 256 * RPF(13); uu += F.G) { const int u = uu & 255;
        const int c = u >> 2, g = u & 3, h = g * 8 + F.wave, t0 = c * 256;
        const float A = -expf(A_log[h]);
        float d4[4], c4[4];
        { const f32x4 dq = *(const f32x4*)(DT + (size_t)h * T + t0 + 4 * lane); d4[0] = dq.x; d4[1] = dq.y; d4[2] = dq.z; d4[3] = dq.w; }
        c4[0] = d4[0] * A; c4[1] = c4[0] + d4[1] * A; c4[2] = c4[1] + d4[2] * A; c4[3] = c4[2] + d4[3] * A;
        float inc = c4[3];
#pragma unroll
        for (int o = 1; o < 64; o <<= 1) { const float n = __shfl_up(inc, o); if (lane >= o) inc += n; }
        const float excl = inc - c4[3];
        const float total = __shfl(inc, 63);
        f32x4 csv; csv.x = excl + c4[0]; csv.y = excl + c4[1]; csv.z = excl + c4[2]; csv.w = excl + c4[3];
        *(f32x4*)(CS + (size_t)h * T + t0 + 4 * lane) = csv;
        if (lane == 0) DECAY[c * 32 + h] = __expf(total);
        f32x4 wv; wv.x = d4[0] * __expf(total - csv.x); wv.y = d4[1] * __expf(total - csv.y); wv.z = d4[2] * __expf(total - csv.z); wv.w = d4[3] * __expf(total - csv.w);
        *(LAS f32x4*)(wl + 4 * lane) = wv;
        LDS_WAIT(); asm volatile("" ::: "memory");
        f32x16 acc[2][4];
#pragma unroll
        for (int pt = 0; pt < 2; ++pt)
#pragma unroll
            for (int nt = 0; nt < 4; ++nt)
#pragma unroll
                for (int i = 0; i < 16; ++i) acc[pt][nt][i] = 0.f;
        const unsigned char* xa = (const unsigned char*)XBT + ((size_t)((h * 2) * 64 + c) * 16) * 1024 + lane * 16; const unsigned char* xb = (const unsigned char*)XBT + ((size_t)((64 + g * 4) * 64 + c) * 16) * 1024 + lane * 16;
#pragma unroll 4
        for (int ks = 0; ks < 16; ++ks) {
            const f32x4 w0 = *(const LAS f32x4*)(wl + 16 * ks + 8 * hh), w1 = *(const LAS f32x4*)(wl + 16 * ks + 8 * hh + 4);
            bf16x8 af[2], bfr[4];
#pragma unroll
            for (int pt = 0; pt < 2; ++pt) af[pt] = scale8(*(const bf16x8*)(xa + (size_t)pt * (64 * 16 * 1024) + ks * 1024), w0, w1);
#pragma unroll
            for (int nt = 0; nt < 4; ++nt) bfr[nt] = *(const bf16x8*)(xb + (size_t)nt * (64 * 16 * 1024) + ks * 1024);
#pragma unroll
            for (int pt = 0; pt < 2; ++pt)
#pragma unroll
                for (int nt = 0; nt < 4; ++nt) acc[pt][nt] = __builtin_amdgcn_mfma_f32_32x32x16_bf16(af[pt], bfr[nt], acc[pt][nt], 0, 0, 0);
        }
        float* sp = STATES + (size_t)(c * 32 + h) * 8192;
#pragma unroll
        for (int pt = 0; pt < 2; ++pt)
#pragma unroll
            for (int nt = 0; nt < 4; ++nt)
#pragma unroll
                for (int i = 0; i < 16; ++i) sp[(size_t)(pt * 32 + (i & 3) + 8 * (i >> 2) + 4 * hh) * 128 + nt * 32 + r] = acc[pt][nt][i];
        LDS_WAIT(); asm volatile("" ::: "memory");
    }
}
__device__ __forceinline__ void ssd_c2(const Args& a, Frame& F) {
    const float* STATES = (const float*)(a.ws + WS_STATES); const float* DECAY = (const float*)(a.ws + WS_DECAY); bf16* PREV = (bf16*)(a.ws + WS_PREV);
    for (int idx = (int)blockIdx.x * (NWAVES * 64) + F.tid; idx < 32 * 64 * 128 / 2 * RPF(14); idx += F.G * NWAVES * 64) {
        const int e0 = (idx & (32 * 64 * 128 / 2 - 1)) * 2, h = e0 >> 13, rest = e0 & 8191;
        float s0 = 0.f, s1 = 0.f;
#pragma unroll 8
        for (int c = 0; c < 64; ++c) {
            const size_t o = (size_t)(c * 32 + h) * 8192 + rest;
            *(unsigned*)(PREV + o) = pk2(s0, s1);
            const float dec = DECAY[c * 32 + h]; const float2 st = *(const float2*)(STATES + o);
            s0 = s0 * dec + st.x; s1 = s1 * dec + st.y;
        }
    }
}
__device__ __forceinline__ v4u ldg16(const void* base, unsigned off) { return *(const v4u*)((const char*)base + off); }
__device__ __forceinline__ unsigned long long ldg8(const void* base, unsigned off) { return *(const unsigned long long*)((const char*)base + off); }
__device__ __forceinline__ void ssd_c3(const Args& a, Frame& F) {
    const unsigned char* ws = a.ws;
    const float* Dsk = (const float*)a.in[8]; const float* snw = (const float*)a.in[9];
    LAS unsigned char* CBL = F.lds + RING_OFF; LAS float* ssp = (LAS float*)(F.lds + SSP_OFF); LAS float* csl = (LAS float*)(F.lds + CSL_OFF + F.wave * 2048); LAS float* dtl = csl + 256;
    const int lane = F.lane, r = lane & 31, hh = lane >> 5, wave = F.wave;
    for (int uu = (int)blockIdx.x; uu < 256 * RPF(5); uu += F.G) { const int u = uu & 255;
        const int c = u >> 2, g = u & 3, t0 = c * 256;
        {
#pragma unroll 1
          for (int idx2 = wave; idx2 < 36 * RPF(20); idx2 += 8) { const int idx = idx2 >= 36 ? idx2 - 36 : idx2; int lt = 0; while ((lt + 1) * (lt + 2) / 2 <= idx) ++lt; const int st = idx - lt * (lt + 1) / 2;
            f32x16 acc;
#pragma unroll
            for (int i = 0; i < 16; ++i) acc[i] = 0.f;
            const unsigned bo = (unsigned)((t0 + st * 32 + r) * NCONV + 2048 + g * 128 + 8 * hh) * 2u, co = (unsigned)((t0 + lt * 32 + r) * NCONV + 2560 + g * 128 + 8 * hh) * 2u;
#pragma unroll
            for (int kn = 0; kn < 8; ++kn) acc = __builtin_amdgcn_mfma_f32_32x32x16_bf16(__builtin_bit_cast(bf16x8, ldg16(ws + WS_XBC, bo + 32 * kn)), __builtin_bit_cast(bf16x8, ldg16(ws + WS_XBC, co + 32 * kn)), acc, 0, 0, 0);
            const int row = lt * 32 + r;
#pragma unroll
            for (int i4 = 0; i4 < 4; ++i4) { const int chunk = st * 4 + i4;
                const unsigned long long w = (unsigned long long)cvtpk(acc[4 * i4], acc[4 * i4 + 1]) | ((unsigned long long)cvtpk(acc[4 * i4 + 2], acc[4 * i4 + 3]) << 32);
                *(LAS unsigned long long*)(CBL + row * 512 + ((chunk ^ (row & 15)) << 4) + 8 * hh) = w; } } }
        __syncthreads();
#pragma unroll 1
        for (int pass2 = 0; pass2 < 2 * RPF(21); ++pass2) { const int pass = pass2 & 1;
            const int e = pass * 4 + (wave >> 1), pt = wave & 1, h = g * 8 + e;
            { const unsigned o4 = (unsigned)(h * T + t0 + 4 * lane) * 4u;
              const f32x4 cv = *(const f32x4*)(ws + WS_CS + o4); const f32x4 dv = *(const f32x4*)(ws + WS_DT + o4);
              *(LAS f32x4*)(csl + 4 * lane) = cv; *(LAS f32x4*)(dtl + 4 * lane) = dv; }
            bf16x8 xa[16], pa[8];
            { const unsigned xo = (unsigned)((h * 64 + pt * 32 + r) * T + t0 + 8 * hh) * 2u;
#pragma unroll
              for (int ks = 0; ks < 16; ++ks) xa[ks] = __builtin_bit_cast(bf16x8, ldg16(ws + WS_XBT, xo + 32 * ks));
              const unsigned po = (unsigned)(((c * 32 + h) * 64 + pt * 32 + r) * 128 + 8 * hh) * 2u;
#pragma unroll
              for (int kn = 0; kn < 8; ++kn) pa[kn] = __builtin_bit_cast(bf16x8, ldg16(ws + WS_PREV, po + 32 * kn)); }
            LDS_WAIT(); asm volatile("" ::: "memory");
            v4u cf[8];
            { const unsigned coff0 = ((unsigned)(t0 + r) * NCONV + 2560 + g * 128 + 8 * hh) * 2u;
#pragma unroll
              for (int kn = 0; kn < 8; ++kn) cf[kn] = ldg16(ws + WS_XBC, coff0 + 32 * kn); }
#pragma unroll 1
            for (int lt = 0; lt < 8; ++lt) {
                int r15 = r & 15; asm volatile("" : "+v"(r15));
                const int lrow = lt * 32 + r, t = t0 + lrow; const float csv = csl[lrow];
                const unsigned pcol = (unsigned)(h * 64 + pt * 32 + 4 * hh);
                const unsigned xoff = ((unsigned)t * NCONV + pcol) * 2u, zoff = ((unsigned)t * NPROJ + pcol) * 2u, moff = ((unsigned)t * DMIX + pcol) * 2u;
                f32x16 ad, ao;
#pragma unroll
                for (int i = 0; i < 16; ++i) ao[i] = 0.f;
#pragma unroll
                for (int kn = 0; kn < 8; ++kn) ao = __builtin_amdgcn_mfma_f32_32x32x16_bf16(pa[kn], __builtin_bit_cast(bf16x8, cf[kn]), ao, 0, 0, 0);
                { const unsigned coff = ((unsigned)(t + (lt < 7 ? 32 : 0)) * NCONV + 2560 + g * 128 + 8 * hh) * 2u;
#pragma unroll
                  for (int kn = 0; kn < 8; ++kn) cf[kn] = ldg16(ws + WS_XBC, coff + 32 * kn); }
                const float el = __expf(csv);
#pragma unroll
                for (int i = 0; i < 16; ++i) ad[i] = el * ao[i];
#pragma unroll
                for (int ks = 0; ks < 16; ++ks) { if (ks < 2 * (lt + 1)) {
                    const int s0 = 16 * ks + 8 * hh;
                    const v4u cb = *(const LAS v4u*)(CBL + lrow * 512 + (((2 * ks + hh) ^ r15) << 4));
                    const f32x4 c0 = *(const LAS f32x4*)(csl + s0), c1 = *(const LAS f32x4*)(csl + s0 + 4), d0 = *(const LAS f32x4*)(dtl + s0), d1 = *(const LAS f32x4*)(dtl + s0 + 4);
                    float m[8];
                    m[0] = bflo(cb.x) * __expf(csv - c0.x) * d0.x; m[1] = bfhi(cb.x) * __expf(csv - c0.y) * d0.y; m[2] = bflo(cb.y) * __expf(csv - c0.z) * d0.z; m[3] = bfhi(cb.y) * __expf(csv - c0.w) * d0.w;
                    m[4] = bflo(cb.z) * __expf(csv - c1.x) * d1.x; m[5] = bfhi(cb.z) * __expf(csv - c1.y) * d1.y; m[6] = bflo(cb.w) * __expf(csv - c1.z) * d1.z; m[7] = bfhi(cb.w) * __expf(csv - c1.w) * d1.w;
                    if (ks >= 2 * lt) {
#pragma unroll
                        for (int j = 0; j < 8; ++j) m[j] = (s0 + j <= lrow) ? m[j] : 0.f; }
                    v4u bo; bo.x = cvtpk(m[0], m[1]); bo.y = cvtpk(m[2], m[3]); bo.z = cvtpk(m[4], m[5]); bo.w = cvtpk(m[6], m[7]);
                    ad = __builtin_amdgcn_mfma_f32_32x32x16_bf16(xa[ks], __builtin_bit_cast(bf16x8, bo), ad, 0, 0, 0); }
                    __builtin_amdgcn_sched_barrier(0); }
#pragma unroll
                for (int i4 = 0; i4 < 4; ++i4)
                    *(unsigned long long*)((unsigned char*)a.ws + WS_MIX + (moff + 16 * i4)) = (unsigned long long)pk2(ad[4 * i4], ad[4 * i4 + 1]) | ((unsigned long long)pk2(ad[4 * i4 + 2], ad[4 * i4 + 3]) << 32);
            }
            LDS_WAIT(); asm volatile("" ::: "memory");
        }
        __syncthreads();
        { const f32x4 w0 = *(const f32x4*)(snw + g * 512 + lane * 8), w1 = *(const f32x4*)(snw + g * 512 + lane * 8 + 4); const float dsk = Dsk[g * 8 + (lane >> 3)];
#pragma unroll 4
          for (int tk = 0; tk < 32; ++tk) { const unsigned tl = (unsigned)(t0 + wave * 32 + tk);
            v4u* mp = (v4u*)((unsigned char*)a.ws + WS_MIX + (tl * DMIX + g * 512 + lane * 8) * 2u); const v4u q = *mp;
            const v4u xv = ldg16(ws + WS_XBC, (tl * NCONV + g * 512 + lane * 8) * 2u), zv = ldg16(ws + WS_PROJ, (tl * NPROJ + g * 512 + lane * 8) * 2u);
            const float f0 = (bflo(q.x) + dsk * bflo(xv.x)) * silu(bflo(zv.x)), f1 = (bfhi(q.x) + dsk * bfhi(xv.x)) * silu(bfhi(zv.x)), f2 = (bflo(q.y) + dsk * bflo(xv.y)) * silu(bflo(zv.y)), f3 = (bfhi(q.y) + dsk * bfhi(xv.y)) * silu(bfhi(zv.y));
            const float f4 = (bflo(q.z) + dsk * bflo(xv.z)) * silu(bflo(zv.z)), f5 = (bfhi(q.z) + dsk * bfhi(xv.z)) * silu(bfhi(zv.z)), f6 = (bflo(q.w) + dsk * bflo(xv.w)) * silu(bflo(zv.w)), f7 = (bfhi(q.w) + dsk * bfhi(xv.w)) * silu(bfhi(zv.w));
            const float tot = wave_sum((f0 * f0 + f1 * f1) + (f2 * f2 + f3 * f3) + (f4 * f4 + f5 * f5) + (f6 * f6 + f7 * f7));
            const float rstd = __builtin_amdgcn_rsqf(tot * (1.0f / 512.0f) + EPS); v4u o;
            o.x = pk2(f0 * rstd * w0.x, f1 * rstd * w0.y); o.y = pk2(f2 * rstd * w0.z, f3 * rstd * w0.w);
            o.z = pk2(f4 * rstd * w1.x, f5 * rstd * w1.y); o.w = pk2(f6 * rstd * w1.z, f7 * rstd * w1.w); *mp = o; } }
        __syncthreads();
    }
}
__device__ __forceinline__ void ssd_c3f(const Args& a, Frame& F) {
    const unsigned char* ws = a.ws;
    const float* Dsk = (const float*)a.in[8]; const float* snw = (const float*)a.in[9];
    LAS unsigned char* BL = F.lds + RING_OFF; LAS unsigned char* CL = BL + 65536; LAS float* csl = (LAS float*)(F.lds + CSL_OFF + F.wave * 2048); LAS float* dtl = csl + 256;
    const int lane = F.lane, r = lane & 31, hh = lane >> 5, wave = F.wave;
    for (int uu = (int)blockIdx.x; uu < 256 * RPF(5); uu += F.G) { const int u = uu & 255;
        const int c = u >> 2, g = u & 3, t0 = c * 256, h = g * 8 + wave;
        { v4u st[16];
#pragma unroll
          for (int i = 0; i < 16; ++i) { const int piece = F.tid + 512 * i, which = piece >> 12, p2 = piece & 4095, row = p2 >> 4, ch = p2 & 15;
              st[i] = ldg16(ws + WS_XBC, ((unsigned)(t0 + row) * NCONV + 2048 + which * 512 + g * 128 + ch * 8) * 2u); }
          __syncthreads();
#pragma unroll
          for (int i = 0; i < 16; ++i) { const int piece = F.tid + 512 * i, which = piece >> 12, p2 = piece & 4095, row = p2 >> 4, ch = p2 & 15;
              *(LAS v4u*)(BL + which * 65536 + row * 256 + ((ch ^ (row & 15)) << 4)) = st[i]; } }
        { const unsigned o4 = (unsigned)(h * T + t0 + 4 * lane) * 4u;
          *(LAS f32x4*)(csl + 4 * lane) = *(const f32x4*)(ws + WS_CS + o4); *(LAS f32x4*)(dtl + 4 * lane) = *(const f32x4*)(ws + WS_DT + o4); }
        bf16x8 pf[2][8];
#pragma unroll
        for (int pt = 0; pt < 2; ++pt) { const unsigned po = (unsigned)(((c * 32 + h) * 64 + pt * 32 + r) * 128 + 8 * hh) * 2u;
#pragma unroll
            for (int kn = 0; kn < 8; ++kn) pf[pt][kn] = __builtin_bit_cast(bf16x8, ldg16(ws + WS_PREV, po + 32 * kn)); }
        __syncthreads();
        const unsigned xrow = (unsigned)(((h * 2) * 64 + c) * 16) * 1024u + lane * 16u;
        v4u xn[2][2];
#pragma unroll
        for (int pt = 0; pt < 2; ++pt)
#pragma unroll
            for (int k2 = 0; k2 < 2; ++k2) xn[pt][k2] = ldg16(ws + WS_XBT, xrow + (unsigned)pt * (64u * 16 * 1024) + (unsigned)k2 * 1024u);
#pragma unroll 1
        for (int lt = 0; lt < 8; ++lt) {
            const int lrow = lt * 32 + r; const float csv = csl[lrow];
            const LAS unsigned char* crow = CL + lrow * 256; const int cx = lrow & 15;
#define CFR(kn) (*(const LAS bf16x8*)(crow + (((2 * (kn) + hh) ^ cx) << 4)))
            f32x16 y[2];
#pragma unroll
            for (int pt = 0; pt < 2; ++pt) {
#pragma unroll
                for (int i = 0; i < 16; ++i) y[pt][i] = 0.f;
#pragma unroll
                for (int kn = 0; kn < 8; ++kn) y[pt] = __builtin_amdgcn_mfma_f32_32x32x16_bf16(CFR(kn), pf[pt][kn], y[pt], 0, 0, 0); }
#pragma unroll
            for (int i = 0; i < 16; ++i) { const float el = __expf(csl[lt * 32 + 4 * hh + (i & 3) + 8 * (i >> 2)]); y[0][i] *= el; y[1][i] *= el; }
#pragma unroll 1
            for (int st = 0; st <= lt; ++st) {
                v4u xl[2][2];
#pragma unroll
                for (int pt = 0; pt < 2; ++pt)
#pragma unroll
                    for (int k2 = 0; k2 < 2; ++k2) xl[pt][k2] = xn[pt][k2];
                { const int nst = st < lt ? st + 1 : 0;
#pragma unroll
                  for (int pt = 0; pt < 2; ++pt)
#pragma unroll
                      for (int k2 = 0; k2 < 2; ++k2) xn[pt][k2] = ldg16(ws + WS_XBT, xrow + (unsigned)pt * (64u * 16 * 1024) + (unsigned)(2 * nst + k2) * 1024u); }
                f32x16 S;
#pragma unroll
                for (int i = 0; i < 16; ++i) S[i] = 0.f;
                const int srow = st * 32 + r; int cxo = cx; asm volatile("" : "+v"(cxo));
                {
                  bf16x8 bq = *(const LAS bf16x8*)(BL + srow * 256 + (((hh) ^ (srow & 15)) << 4)), cq = *(const LAS bf16x8*)(crow + (((hh) ^ cxo) << 4));
#pragma unroll
                  for (int kn = 0; kn < 8; ++kn) { bf16x8 bn = bq, cn = cq;
                      if (kn < 7) { bn = *(const LAS bf16x8*)(BL + srow * 256 + (((2 * (kn + 1) + hh) ^ (srow & 15)) << 4)); cn = *(const LAS bf16x8*)(crow + (((2 * (kn + 1) + hh) ^ cxo) << 4)); }
                      S = __builtin_amdgcn_mfma_f32_32x32x16_bf16(bq, cq, S, 0, 0, 0); bq = bn; cq = cn; } }
                float m[16];
#pragma unroll
                for (int i4 = 0; i4 < 4; ++i4) { const int sb = st * 32 + 4 * hh + 8 * i4; const f32x4 c4 = *(const LAS f32x4*)(csl + sb), d4 = *(const LAS f32x4*)(dtl + sb);
                    m[4 * i4] = S[4 * i4] * __expf(csv - c4.x) * d4.x; m[4 * i4 + 1] = S[4 * i4 + 1] * __expf(csv - c4.y) * d4.y; m[4 * i4 + 2] = S[4 * i4 + 2] * __expf(csv - c4.z) * d4.z; m[4 * i4 + 3] = S[4 * i4 + 3] * __expf(csv - c4.w) * d4.w; }
                if (st == lt) {
#pragma unroll
                    for (int i = 0; i < 16; ++i) m[i] = (4 * hh + (i & 3) + 8 * (i >> 2) <= r) ? m[i] : 0.f; }
#pragma unroll
                for (int k2 = 0; k2 < 2; ++k2) { v4u bo; bo.x = cvtpk(m[8 * k2], m[8 * k2 + 1]); bo.y = cvtpk(m[8 * k2 + 2], m[8 * k2 + 3]); bo.z = cvtpk(m[8 * k2 + 4], m[8 * k2 + 5]); bo.w = cvtpk(m[8 * k2 + 6], m[8 * k2 + 7]);
#pragma unroll
                    for (int pt = 0; pt < 2; ++pt) { v4u xa = xl[pt][k2];
                        { const auto r0 = __builtin_amdgcn_permlane32_swap(xa.x, xa.z, false, false); xa.x = r0[0]; xa.z = r0[1]; const auto r1 = __builtin_amdgcn_permlane32_swap(xa.y, xa.w, false, false); xa.y = r1[0]; xa.w = r1[1]; }
                        y[pt] = __builtin_amdgcn_mfma_f32_32x32x16_bf16(__builtin_bit_cast(bf16x8, bo), __builtin_bit_cast(bf16x8, xa), y[pt], 0, 0, 0); } }
            }
#undef CFR
            { unsigned lmo = ((unsigned)(4 * hh) * DMIX + h * 64 + r) * 2u; asm volatile("" : "+v"(lmo));
#pragma unroll
              for (int i = 0; i < 16; ++i) { unsigned char* rp = (unsigned char*)a.ws + WS_MIX + (size_t)(t0 + lt * 32 + (i & 3) + 8 * (i >> 2)) * (DMIX * 2) + lmo;
                  *(bf16*)rp = (bf16)f2bf(y[0][i]); *(bf16*)(rp + 64) = (bf16)f2bf(y[1][i]); } }
        }
        __syncthreads();
        { const f32x4 w0 = *(const f32x4*)(snw + g * 512 + lane * 8), w1 = *(const f32x4*)(snw + g * 512 + lane * 8 + 4); const float dsk = Dsk[g * 8 + (lane >> 3)];
          v4u qb[4], xb[4], zb[4];
#define C3_SWEEP_LOADS(Q_, X_, Z_, tb_) { _Pragma("unroll") for (int k = 0; k < 4; ++k) { const unsigned tl_ = (unsigned)(t0 + wave * 32 + 4 * (tb_) + k); \
              Q_[k] = ldg16(ws + WS_MIX, (tl_ * DMIX + g * 512 + lane * 8) * 2u); X_[k] = ldg16(ws + WS_XBC, (tl_ * NCONV + g * 512 + lane * 8) * 2u); Z_[k] = ldg16(ws + WS_PROJ, (tl_ * NPROJ + g * 512 + lane * 8) * 2u); } }
          C3_SWEEP_LOADS(qb, xb, zb, 0);
#pragma unroll 1
          for (int tb = 0; tb < 8; ++tb) {
          v4u qn[4], xn[4], zn[4];
          C3_SWEEP_LOADS(qn, xn, zn, (tb < 7 ? tb + 1 : tb));
#pragma unroll
          for (int k = 0; k < 4; ++k) { const unsigned tl = (unsigned)(t0 + wave * 32 + 4 * tb + k);
            v4u* mp = (v4u*)((unsigned char*)a.ws + WS_MIX + (tl * DMIX + g * 512 + lane * 8) * 2u); const v4u q = qb[k];
            const v4u xv = xb[k], zv = zb[k];
            const float f0 = (bflo(q.x) + dsk * bflo(xv.x)) * silu(bflo(zv.x)), f1 = (bfhi(q.x) + dsk * bfhi(xv.x)) * silu(bfhi(zv.x)), f2 = (bflo(q.y) + dsk * bflo(xv.y)) * silu(bflo(zv.y)), f3 = (bfhi(q.y) + dsk * bfhi(xv.y)) * silu(bfhi(zv.y));
            const float f4 = (bflo(q.z) + dsk * bflo(xv.z)) * silu(bflo(zv.z)), f5 = (bfhi(q.z) + dsk * bfhi(xv.z)) * silu(bfhi(zv.z)), f6 = (bflo(q.w) + dsk * bflo(xv.w)) * silu(bflo(zv.w)), f7 = (bfhi(q.w) + dsk * bfhi(xv.w)) * silu(bfhi(zv.w));
            const float tot = wave_sum((f0 * f0 + f1 * f1) + (f2 * f2 + f3 * f3) + (f4 * f4 + f5 * f5) + (f6 * f6 + f7 * f7));
            const float rstd = __builtin_amdgcn_rsqf(tot * (1.0f / 512.0f) + EPS); v4u o;
            o.x = pk2(f0 * rstd * w0.x, f1 * rstd * w0.y); o.y = pk2(f2 * rstd * w0.z, f3 * rstd * w0.w);
            o.z = pk2(f4 * rstd * w1.x, f5 * rstd * w1.y); o.w = pk2(f6 * rstd * w1.z, f7 * rstd * w1.w); *mp = o; }
#pragma unroll
          for (int k = 0; k < 4; ++k) { qb[k] = qn[k]; xb[k] = xn[k]; zb[k] = zn[k]; }
          }
#undef C3_SWEEP_LOADS
        }
        __syncthreads();
    }
}
typedef float v2f_t __attribute__((ext_vector_type(2)));
typedef short v4i16_t __attribute__((ext_vector_type(4)));
__device__ __forceinline__ v4i16_t lds_tr16(LAS unsigned char* p) { return __builtin_amdgcn_ds_read_tr16_b64_v4i16((LAS v4i16_t*)p); }
__device__ __forceinline__ void attn_mfma(const Args& a, Frame& F) {
    const unsigned char* ws = a.ws;
    LAS unsigned char* KL = F.lds + RING_OFF; LAS unsigned char* VL = KL + 384 * 144;
    const int lane = F.lane, r = lane & 31, hh = lane >> 5, wave = F.wave;
    const int trb = (4 * hh + ((lane & 15) >> 2)) * 144 + ((lane >> 4) & 1) * 32 + (lane & 3) * 8;
    const float NEG = -__builtin_inff();
    v4u st[12];
#define ATTN_STAGE_LOADS(ITEM) do { const int it_ = (ITEM) >= 3072 ? (ITEM) - 3072 : (ITEM); const int br_ = it_ >> 10, x_ = it_ & 1023, h_ = x_ & 15, y_ = x_ >> 4, dsh_ = 2 * br_, d_ = 1 << dsh_, res_ = y_ & (d_ - 1), n0b_ = (y_ >> dsh_) * 256; \
        _Pragma("unroll") for (int i = 0; i < 12; ++i) { const int piece = F.tid + 512 * i, which = piece >= 3072, p2 = piece - which * 3072, row = p2 >> 3, c = p2 & 7; int n = n0b_ - 128 + row; n = n < 0 ? 0 : n; \
            st[i] = ldg16(ws + WS_PROJ, ((unsigned)((n << dsh_) + res_) * NPROJ + 6144 + which * 1024 + h_ * 64 + 8 * c) * 2u); } } while (0)
    if ((int)blockIdx.x < 3072 * RPF(3)) ATTN_STAGE_LOADS((int)blockIdx.x);
    for (int itt = (int)blockIdx.x; itt < 3072 * RPF(3); itt += F.G) { const int it = itt >= 3072 ? itt - 3072 : itt;
        const int br = it >> 10, x = it & 1023, h = x & 15, y = x >> 4;
        const int dsh = 2 * br, d = 1 << dsh, res = y & (d - 1), n0b = (y >> dsh) * 256, n0 = n0b + 32 * wave;
        const int tq = ((n0 + r) << dsh) + res;
        bf16x8 qf[4];
        { const unsigned qo = ((unsigned)tq * NPROJ + 5120 + h * 64 + 8 * hh) * 2u;
#pragma unroll
          for (int ks = 0; ks < 4; ++ks) qf[ks] = __builtin_bit_cast(bf16x8, ldg16(ws + WS_PROJ, qo + 32 * ks)); }
        { __syncthreads();
#pragma unroll
          for (int i = 0; i < 12; ++i) { const int piece = F.tid + 512 * i, which = piece >= 3072, p2 = piece - which * 3072, row = p2 >> 3, c = p2 & 7;
              *(LAS v4u*)(KL + which * (384 * 144) + row * 144 + 16 * c) = st[i]; }
          __syncthreads();
          if (itt + F.G < 3072 * RPF(3)) ATTN_STAGE_LOADS(itt + F.G); }
        f32x16 S[5];
#pragma unroll
        for (int kt = 0; kt < 5; ++kt) {
            const LAS unsigned char* kp = KL + (32 * wave + 32 * kt + r) * 144 + 16 * hh;
#pragma unroll
            for (int i = 0; i < 16; ++i) S[kt][i] = 0.f;
            { bf16x8 kq = *(const LAS bf16x8*)(kp);
#pragma unroll
              for (int ks = 0; ks < 4; ++ks) { bf16x8 kn_ = kq; if (ks < 3) kn_ = *(const LAS bf16x8*)(kp + 32 * (ks + 1)); __builtin_amdgcn_sched_barrier(0); S[kt] = __builtin_amdgcn_mfma_f32_32x32x16_bf16(kq, qf[ks], S[kt], 0, 0, 0); kq = kn_; } }
        }
#pragma unroll
        for (int i = 0; i < 16; ++i) { const int j = (i & 3) + 8 * (i >> 2) + 4 * hh; S[0][i] = (j >= r) ? S[0][i] : NEG; S[4][i] = (j <= r) ? S[4][i] : NEG; }
        if (n0 < 128) {
#pragma unroll
            for (int kt = 0; kt < 4; ++kt)
#pragma unroll
                for (int i = 0; i < 16; ++i) { const int j = (i & 3) + 8 * (i >> 2) + 4 * hh; S[kt][i] = (n0 - 128 + 32 * kt + j >= 0) ? S[kt][i] : NEG; }
        }
        float m = NEG;
#pragma unroll
        for (int kt = 0; kt < 5; ++kt)
#pragma unroll
            for (int i = 0; i < 16; ++i) m = fmaxf(m, S[kt][i]);
        m = fmaxf(m, __shfl_xor(m, 32));
        v2f_t l2 = {0.f, 0.f}; const v2f_t m2 = {m, m};
#pragma unroll
        for (int kt = 0; kt < 5; ++kt)
#pragma unroll
            for (int i = 0; i < 16; i += 2) { v2f_t x = {S[kt][i], S[kt][i + 1]}; x = x - m2; x.x = __builtin_amdgcn_exp2f(x.x); x.y = __builtin_amdgcn_exp2f(x.y); l2 += x; S[kt][i] = x.x; S[kt][i + 1] = x.y; }
        float l = l2.x + l2.y;
        l += __shfl_xor(l, 32);
        f32x16 O[2];
#pragma unroll
        for (int i = 0; i < 16; ++i) { O[0][i] = 0.f; O[1][i] = 0.f; }
#pragma unroll
        for (int kt = 0; kt < 5; ++kt) {
            LAS unsigned char* vp = VL + (32 * wave + 32 * kt) * 144 + trb;
#pragma unroll
            for (int s2 = 0; s2 < 2; ++s2) {
                v4u pb; pb.x = cvtpk(S[kt][8 * s2], S[kt][8 * s2 + 1]); pb.y = cvtpk(S[kt][8 * s2 + 2], S[kt][8 * s2 + 3]); pb.z = cvtpk(S[kt][8 * s2 + 4], S[kt][8 * s2 + 5]); pb.w = cvtpk(S[kt][8 * s2 + 6], S[kt][8 * s2 + 7]);
#pragma unroll
                for (int dvt = 0; dvt < 2; ++dvt) {
                    const v4i16_t lo = lds_tr16(vp + (16 * s2) * 144 + dvt * 64), hi = lds_tr16(vp + (16 * s2 + 8) * 144 + dvt * 64);
                    const bf16x8 af = {lo[0], lo[1], lo[2], lo[3], hi[0], hi[1], hi[2], hi[3]};
                    O[dvt] = __builtin_amdgcn_mfma_f32_32x32x16_bf16(__builtin_bit_cast(bf16x8, pb), af, O[dvt], 0, 0, 0); } }
        }
        const float inv = 1.0f / l;
#pragma unroll
        for (int i = 0; i < 16; ++i) { const int qi = (i & 3) + 8 * (i >> 2) + 4 * hh;
            const float invq = __shfl(inv, qi);
            const unsigned oo = (((unsigned)br * T + (((n0 + qi) << dsh) + res)) * 1024u + h * 64 + r) * 2u;
            *(bf16*)((unsigned char*)a.ws + WS_OP + oo) = (bf16)f2bf(O[0][i] * invq); *(bf16*)((unsigned char*)a.ws + WS_OP + oo + 64) = (bf16)f2bf(O[1][i] * invq); }
        if (hh == 0) { float2 ml; ml.x = m; ml.y = l; *(float2*)((unsigned char*)a.ws + WS_ML + (((unsigned)br * T + tq) * 16u + h) * 8u) = ml; }
    }
    __syncthreads();
}
#undef ATTN_STAGE_LOADS
__device__ __forceinline__ void attn_combine(const Args& a, Frame& F) {
    const unsigned char* ws = a.ws; const int lane = F.lane, h = lane >> 2, sub = lane & 3;
    float2 mlc[3]; v4u uc[3][2]; int tt = F.gw;
#define AC_LOAD(ML_, U_, t_) { _Pragma("unroll") for (int b = 0; b < 3; ++b) { ML_[b] = *(const float2*)(ws + WS_ML + (((unsigned)b * T + (t_)) * 16u + h) * 8u); \
            const unsigned off = (((unsigned)b * T + (t_)) * 1024u + h * 64 + sub * 16) * 2u; U_[b][0] = ldg16(ws + WS_OP, off); U_[b][1] = ldg16(ws + WS_OP, off + 16); } }
    if (tt < T * RPF(4)) AC_LOAD(mlc, uc, tt & (T - 1));
#pragma unroll 1
    for (; tt < T * RPF(4); tt += F.NGW) { const int t = tt & (T - 1);
        float2 mln[3]; v4u un[3][2];
        { const int tn = (tt + F.NGW < T * RPF(4)) ? ((tt + F.NGW) & (T - 1)) : t; AC_LOAD(mln, un, tn); }
        float mb[3], lb[3];
#pragma unroll
        for (int b = 0; b < 3; ++b) { mb[b] = mlc[b].x; lb[b] = mlc[b].y; }
        const float M = fmaxf(mb[0], fmaxf(mb[1], mb[2]));
        const float w0 = __builtin_amdgcn_exp2f(mb[0] - M) * lb[0], w1 = __builtin_amdgcn_exp2f(mb[1] - M) * lb[1], w2 = __builtin_amdgcn_exp2f(mb[2] - M) * lb[2]; const float iw = 1.0f / (w0 + w1 + w2);
        const float wb[3] = {w0 * iw, w1 * iw, w2 * iw};
        float o[16];
#pragma unroll
        for (int i = 0; i < 16; ++i) o[i] = 0.f;
#pragma unroll
        for (int b = 0; b < 3; ++b) { const v4u u0 = uc[b][0], u1 = uc[b][1];
            o[0] += wb[b] * bflo(u0.x); o[1] += wb[b] * bfhi(u0.x); o[2] += wb[b] * bflo(u0.y); o[3] += wb[b] * bfhi(u0.y); o[4] += wb[b] * bflo(u0.z); o[5] += wb[b] * bfhi(u0.z); o[6] += wb[b] * bflo(u0.w); o[7] += wb[b] * bfhi(u0.w);
            o[8] += wb[b] * bflo(u1.x); o[9] += wb[b] * bfhi(u1.x); o[10] += wb[b] * bflo(u1.y); o[11] += wb[b] * bfhi(u1.y); o[12] += wb[b] * bflo(u1.z); o[13] += wb[b] * bfhi(u1.z); o[14] += wb[b] * bflo(u1.w); o[15] += wb[b] * bfhi(u1.w); }
        v4u q0, q1; q0.x = pk2(o[0], o[1]); q0.y = pk2(o[2], o[3]); q0.z = pk2(o[4], o[5]); q0.w = pk2(o[6], o[7]); q1.x = pk2(o[8], o[9]); q1.y = pk2(o[10], o[11]); q1.z = pk2(o[12], o[13]); q1.w = pk2(o[14], o[15]);
        v4u* dst = (v4u*)((unsigned char*)a.ws + WS_MIX + ((unsigned)t * DMIX + 2048 + h * 64 + sub * 16) * 2u); dst[0] = q0; dst[1] = q1;
#pragma unroll
        for (int b = 0; b < 3; ++b) { mlc[b] = mln[b]; uc[b][0] = un[b][0]; uc[b][1] = un[b][1]; }
    }
#undef AC_LOAD
}

__device__ __forceinline__ void p7_router(const Args& a, Frame& F) {
    const float* hres = a.out; const float* n2w = (const float*)a.in[13];
    const float* bgr = (const float*)a.in[15]; const float* ber = (const float*)a.in[17];
    const bf16* WRH = (const bf16*)(a.ws + WS_WR); const bf16* WRL = WRH + 80 * D;
    int* EID = (int*)(a.ws + WS_EID); float* GATE = (float*)(a.ws + WS_GATE); int* POS = (int*)(a.ws + WS_POS); int* HIST = (int*)(a.ws + WS_HIST); float* RSTD = (float*)(a.ws + WS_RSTD);
    LAS float* part = (LAS float*)(F.lds + RING_OFF); LAS float* ssl = (LAS float*)(F.lds + RING_OFF + 81920); LAS float* lg = (LAS float*)(F.lds + RING_OFF + 83968); LAS int* hl = (LAS int*)(F.lds + TAB_OFF);
    if (F.tid < 64) hl[F.tid] = 0;
    __syncthreads();
    const int lane = F.lane, row = lane & 15, g4 = lane >> 4, k0 = F.wave * 256;
    for (int it = (int)blockIdx.x; it < T / 32; it += F.G) {
        const int t0 = it * 32;
        const float* hrow = hres + (size_t)(t0 + row) * D + k0 + 8 * g4; const float* wrow = n2w + k0 + 8 * g4;
        const bf16* bh0 = WRH + (size_t)(F.wave * 8) * 512 + lane * 8; const bf16* bl0 = WRL + (size_t)(F.wave * 8) * 512 + lane * 8;
        unsigned char* h8row = (unsigned char*)(a.ws + WS_HN8) + (size_t)(t0 + row) * D + k0 + 8 * g4;
        f32x4 acc[2][5]; float ss[2] = {0.f, 0.f};
#pragma unroll
        for (int rt = 0; rt < 2; ++rt)
#pragma unroll
            for (int ct = 0; ct < 5; ++ct) acc[rt][ct] = (f32x4){0.f, 0.f, 0.f, 0.f};
#pragma unroll 1
        for (int kh = 0; kh < 2; ++kh) {
        unsigned long long h8v[2][4];
#pragma unroll
        for (int k4 = 0; k4 < 4; ++k4) { const int ks = kh * 4 + k4;
            const f32x4 w0 = *(const f32x4*)(wrow + 32 * ks), w1 = *(const f32x4*)(wrow + 32 * ks + 4);
            bf16x8 ah[2], al[2];
#pragma unroll
            for (int rt = 0; rt < 2; ++rt) {
                const f32x4 a0 = *(const f32x4*)(hrow + (size_t)(rt * 16) * D + 32 * ks), a1 = *(const f32x4*)(hrow + (size_t)(rt * 16) * D + 32 * ks + 4);
                ss[rt] += (a0.x * a0.x + a0.y * a0.y) + (a0.z * a0.z + a0.w * a0.w) + (a1.x * a1.x + a1.y * a1.y) + (a1.z * a1.z + a1.w * a1.w);
                const f32x4 v0 = a0 * w0, v1 = a1 * w1;
                v4u hi; hi.x = cvtpk(v0.x, v0.y); hi.y = cvtpk(v0.z, v0.w); hi.z = cvtpk(v1.x, v1.y); hi.w = cvtpk(v1.z, v1.w);
                v4u lo; lo.x = cvtpk(v0.x - bflo(hi.x), v0.y - bfhi(hi.x)); lo.y = cvtpk(v0.z - bflo(hi.y), v0.w - bfhi(hi.y)); lo.z = cvtpk(v1.x - bflo(hi.z), v1.y - bfhi(hi.z)); lo.w = cvtpk(v1.z - bflo(hi.w), v1.w - bfhi(hi.w));
                h8v[rt][k4] = (unsigned long long)fp8x4(v0.x, v0.y, v0.z, v0.w) | ((unsigned long long)fp8x4(v1.x, v1.y, v1.z, v1.w) << 32);
                ah[rt] = __builtin_bit_cast(bf16x8, hi); al[rt] = __builtin_bit_cast(bf16x8, lo); }
#pragma unroll
            for (int ct = 0; ct < 5; ++ct) { const bf16x8 bh = *(const bf16x8*)(bh0 + (size_t)(ct * 64 + ks) * 512), bl = *(const bf16x8*)(bl0 + (size_t)(ct * 64 + ks) * 512);
#pragma unroll
                for (int rt = 0; rt < 2; ++rt) { acc[rt][ct] = __builtin_amdgcn_mfma_f32_16x16x32_bf16(ah[rt], bh, acc[rt][ct], 0, 0, 0); acc[rt][ct] = __builtin_amdgcn_mfma_f32_16x16x32_bf16(ah[rt], bl, acc[rt][ct], 0, 0, 0); acc[rt][ct] = __builtin_amdgcn_mfma_f32_16x16x32_bf16(al[rt], bh, acc[rt][ct], 0, 0, 0); } }
        }
#if MOE_FP8
#pragma unroll
        for (int rt = 0; rt < 2; ++rt)
#pragma unroll
            for (int k4 = 0; k4 < 4; ++k4) *(unsigned long long*)(h8row + (size_t)(rt * 16) * D + 32 * (kh * 4 + k4)) = h8v[rt][k4];
#endif
        }
#pragma unroll
        for (int rt = 0; rt < 2; ++rt) { ss[rt] += __shfl_xor(ss[rt], 16); ss[rt] += __shfl_xor(ss[rt], 32); }
#pragma unroll
        for (int rt = 0; rt < 2; ++rt)
#pragma unroll
            for (int ct = 0; ct < 5; ++ct)
#pragma unroll
                for (int r = 0; r < 4; ++r) part[F.wave * 2560 + (rt * 16 + g4 * 4 + r) * 80 + ct * 16 + row] = acc[rt][ct][r];
        if (g4 == 0) { ssl[F.wave * 32 + row] = ss[0]; ssl[F.wave * 32 + 16 + row] = ss[1]; }
        __syncthreads();
        for (int idx = F.tid; idx < 2560; idx += NWAVES * 64) { float v = 0.f;
#pragma unroll
            for (int w = 0; w < 8; ++w) v += part[w * 2560 + idx];
            lg[idx] = v; }
        __syncthreads();
        if (F.tid < 32) { const int t = t0 + F.tid; const LAS float* q = lg + F.tid * 80;
            float sq = 0.f;
#pragma unroll
            for (int w = 0; w < 8; ++w) sq += ssl[w * 32 + F.tid];
            const float rstd = 1.0f / sqrtf(sq * (1.0f / D) + EPS); RSTD[t] = rstd;
            float gmax = -__builtin_inff(); int gi = 0; float gl[8];
#pragma unroll
            for (int c = 0; c < 8; ++c) { gl[c] = q[c] * rstd + bgr[c]; if (gl[c] > gmax) { gmax = gl[c]; gi = c; } }
            float gsum = 0.f;
#pragma unroll
            for (int c = 0; c < 8; ++c) gsum += expf(gl[c] - gmax);
            const float gval = 1.0f / gsum;
            float e1 = -__builtin_inff(), e2 = -__builtin_inff(); int i1 = 0, i2 = 0; float el[8];
#pragma unroll
            for (int c = 0; c < 8; ++c) { el[c] = q[8 + gi * 8 + c] * rstd + ber[gi * 8 + c]; if (el[c] > e1) { e1 = el[c]; i1 = c; } }
#pragma unroll
            for (int c = 0; c < 8; ++c) { if (c != i1 && el[c] > e2) { e2 = el[c]; i2 = c; } }
            const float rr = expf(e2 - e1); const float w1 = 1.0f / (1.0f + rr), w2 = rr / (1.0f + rr);
            const int ea = gi * 8 + i1, eb = gi * 8 + i2;
            const int pa = __hip_atomic_fetch_add(hl + ea, 1, __ATOMIC_RELAXED, __HIP_MEMORY_SCOPE_WORKGROUP), pb = __hip_atomic_fetch_add(hl + eb, 1, __ATOMIC_RELAXED, __HIP_MEMORY_SCOPE_WORKGROUP);
            EID[2 * t] = ea; EID[2 * t + 1] = eb; GATE[2 * t] = gval * w1; GATE[2 * t + 1] = gval * w2; POS[2 * t] = ((int)blockIdx.x << 16) | pa; POS[2 * t + 1] = ((int)blockIdx.x << 16) | pb; }
        __syncthreads();
    }
    if (F.tid < 64) HIST[(int)blockIdx.x * 64 + F.tid] = hl[F.tid];
}

__device__ __forceinline__ void p8_offsets(const Args& a, Frame& F) {
    LAS int* tab = (LAS int*)(F.lds + TAB_OFF); LAS int* bt = (LAS int*)(F.lds + RING_OFF);
    const int* HIST = (const int*)(a.ws + WS_HIST);
    for (int i = F.tid; i < 256 * 64; i += NWAVES * 64) bt[i] = (i < F.G * 64) ? HIST[i] : 0;
    __syncthreads();
    if (F.tid < 64) { int run = 0; for (int b = 0; b < 256; ++b) { const int c = bt[b * 64 + F.tid]; bt[b * 64 + F.tid] = run; run += c; } tab[128 + F.tid] = run; tab[192 + F.tid] = (run + 255) & ~255; }
    __syncthreads();
    if (F.tid == 0) { int run = 0; for (int e = 0; e < 64; ++e) { tab[e] = run; run += tab[192 + e]; } tab[64] = run; }
    __syncthreads();
}
__device__ __forceinline__ void p8_gather(const Args& a, Frame& F) {
    p8_offsets(a, F);
    LAS int* tab = (LAS int*)(F.lds + TAB_OFF); LAS int* bt = (LAS int*)(F.lds + RING_OFF);
    const int R = tab[64];
    int* TILE = (int*)(a.ws + WS_TILE);
    if (blockIdx.x == 0) {
        for (int pm = F.tid; pm < R / 256; pm += NWAVES * 64) { int e = 0; for (int q = 1; q < 64; ++q) if (tab[q] <= pm * 256) e = q; TILE[pm] = e; }
        if (F.tid == 0) TILE[255] = R / 256;
    }
    const float* hres = a.out; const float* n2w = (const float*)a.in[13]; const float* RSTD = (const float*)(a.ws + WS_RSTD); bf16* XG = (bf16*)(a.ws + WS_XG);
    const int* EID = (const int*)(a.ws + WS_EID); const int* POS = (const int*)(a.ws + WS_POS); int* DEST = (int*)(a.ws + WS_DEST);
    for (int ass = F.gw; ass < 2 * T * RPF(8); ass += F.NGW) { const int as = ass & (2 * T - 1);
        const int e = EID[as], pp = POS[as], dest = tab[e] + bt[(pp >> 16) * 64 + e] + (pp & 0xffff);
        if (F.lane == 0) { DEST[as] = dest; ((float*)(a.ws + WS_ROWRS))[dest] = RSTD[as >> 1]; }
#if MOE_FP8
        { const v4u* s8 = (const v4u*)((const unsigned char*)(a.ws + WS_HN8) + (size_t)(as >> 1) * D) + F.lane; const v4u q0 = s8[0], q1 = s8[64];
          v4u* d8 = (v4u*)((unsigned char*)XG + (size_t)dest * D) + F.lane; d8[0] = q0; d8[64] = q1; }
#else
        { const int t = as >> 1; const float rstd = RSTD[t]; const GAS f32x4* xr = (const GAS f32x4*)(hres + (size_t)t * D) + F.lane; const GAS f32x4* wr = (const GAS f32x4*)n2w + F.lane;
          GAS unsigned long long* o8 = (GAS unsigned long long*)(XG + (size_t)dest * D) + F.lane;
#pragma unroll
          for (int j = 0; j < 8; ++j) { const f32x4 o = xr[64 * j] * rstd * wr[64 * j]; o8[64 * j] = (unsigned long long)pk2(o.x, o.y) | ((unsigned long long)pk2(o.z, o.w) << 32); } }
#endif
    }
}
__device__ __forceinline__ int moe_slot(const Frame& F) { const int c = (int)blockIdx.x; return (F.G & 7) ? c : (c & 7) * (F.G >> 3) + (c >> 3); }
__device__ __forceinline__ int moe_tiles_to_lds(const Args& a, Frame& F) {
    LAS int* tab = (LAS int*)(F.lds + TAB_OFF); const int* TILE = (const int*)(a.ws + WS_TILE);
    if (F.tid < 256) tab[F.tid] = TILE[F.tid];
    __syncthreads();
    return __builtin_amdgcn_readfirstlane(tab[255]);
}

__device__ __forceinline__ void p11_combine(const Args& a, Frame& F) {
#if MOE_FP8
    const unsigned char* Y = (const unsigned char*)(a.ws + WS_Y); const int* DEST = (const int*)(a.ws + WS_DEST); const float* GATE = (const float*)(a.ws + WS_GATE); float* out = a.out;
    for (int t = F.gw; t < T; t += F.NGW) {
        const int d0 = DEST[2 * t], d1 = DEST[2 * t + 1]; const float g0 = GATE[2 * t] * 0.125f, g1 = GATE[2 * t + 1] * 0.125f;
        GAS f32x4* o = (GAS f32x4*)(out + (size_t)t * D) + F.lane;
        const GAS unsigned* y0 = (const GAS unsigned*)(Y + (size_t)d0 * D) + F.lane; const GAS unsigned* y1 = (const GAS unsigned*)(Y + (size_t)d1 * D) + F.lane;
#pragma unroll
        for (int j = 0; j < 8; ++j) { f32x4 v = o[64 * j]; const unsigned u0 = y0[64 * j], u1 = y1[64 * j];
            const v2f_t a0 = __builtin_amdgcn_cvt_pk_f32_fp8((int)u0, false), a1 = __builtin_amdgcn_cvt_pk_f32_fp8((int)u0, true), b0 = __builtin_amdgcn_cvt_pk_f32_fp8((int)u1, false), b1 = __builtin_amdgcn_cvt_pk_f32_fp8((int)u1, true);
            v.x += g0 * a0.x + g1 * b0.x; v.y += g0 * a0.y + g1 * b0.y; v.z += g0 * a1.x + g1 * b1.x; v.w += g0 * a1.y + g1 * b1.y;
            o[64 * j] = v; }
    }
#else
    const bf16* Y = (const bf16*)(a.ws + WS_Y); const int* DEST = (const int*)(a.ws + WS_DEST); const float* GATE = (const float*)(a.ws + WS_GATE); float* out = a.out;
    for (int t = F.gw; t < T; t += F.NGW) {
        const int d0 = DEST[2 * t], d1 = DEST[2 * t + 1]; const float g0 = GATE[2 * t], g1 = GATE[2 * t + 1];
        GAS f32x4* o = (GAS f32x4*)(out + (size_t)t * D) + F.lane;
        const GAS unsigned long long* y0 = (const GAS unsigned long long*)(Y + (size_t)d0 * D) + F.lane; const GAS unsigned long long* y1 = (const GAS unsigned long long*)(Y + (size_t)d1 * D) + F.lane;
#pragma unroll
        for (int j = 0; j < 8; ++j) { f32x4 v = o[64 * j]; const unsigned long long u0 = y0[64 * j], u1 = y1[64 * j];
            v.x += g0 * bflo((unsigned)u0) + g1 * bflo((unsigned)u1); v.y += g0 * bfhi((unsigned)u0) + g1 * bfhi((unsigned)u1);
            v.z += g0 * bflo((unsigned)(u0 >> 32)) + g1 * bflo((unsigned)(u1 >> 32)); v.w += g0 * bfhi((unsigned)(u0 >> 32)) + g1 * bfhi((unsigned)(u1 >> 32));
            o[64 * j] = v; }
    }
#endif
}

constexpr int NPHASE = 12;
__global__ void __launch_bounds__(NWAVES * 64, 2) hymba_fwd(Args args) {
    extern __shared__ __attribute__((aligned(16))) unsigned char lds[];
    Frame F;
    F.lds = (LAS unsigned char*)lds;
    F.MISC = (volatile LAS unsigned*)(F.lds + MISC_OFF);
    F.tid = threadIdx.x; F.lane = F.tid & 63; F.wave = __builtin_amdgcn_readfirstlane(F.tid >> 6);
    F.G = gridDim.x; { const int bx = blockIdx.x; F.vcu = (F.G % 8 == 0) ? (bx % 8) * (F.G / 8) + bx / 8 : bx; }
    F.gw = F.vcu * NWAVES + F.wave; F.NGW = F.G * NWAVES;
    F.ctl = (gu32*)(args.ws + WS_CTL);
    for (int u = F.tid; u < (LDS_BYTES - LDSCTL_OFF) / 4; u += NWAVES * 64) ((LAS unsigned*)(F.lds + LDSCTL_OFF))[u] = 0u;
    __syncthreads();
    const int lo = args.ph_lo, hi = args.ph_hi;
    const bool fused = (hi - lo) > 1;
    XcdBarrier bar; bar.bar = (unsigned*)(F.ctl + CW_BAR); bar.x = 0; bar.st = nullptr;
    if (fused) bar = xcd_barrier_post((unsigned*)(F.ctl + CW_BAR), F.MISC + 8);
#define IN(k) (lo <= (k) && (k) < hi)
#define SEAM(k) do { if (IN(k) && IN((k) + 1)) xcd_barrier(bar); } while (0)
#define REPN(k) ((((REP_MASK) >> (k)) & 1) ? 2 : 1)
#define REPLOOP(k) _Pragma("unroll 1") for (int rp_ = 0; rp_ < REPN(k); ++rp_)
#define REPBAR() do { if (rp_) xcd_barrier(bar); } while (0)

    if (IN(0)) { p0_prologue(args, F); SEAM(0); }
    if (IN(1)) {
        const int bx = (int)blockIdx.x; const bool split = MOE_CONV_IN_P1 && F.G == 256; const bool conv = split && ((bx >> 3) & 3) == 3;
        if (MOE_CONV_IN_P1 && !split) moe_weight_items(args, F.gw, F.NGW, F.lane);
        if (conv) moe_weight_items(args, ((bx >> 5) * 8 + (bx & 7)) * NWAVES + F.wave, 64 * NWAVES, F.lane);
        else {
        constexpr int NBF = MOE_FP8 ? 5120 : NPROJ;
#if MOE_FP8 && P1_INTERLEAVE
        { pg8::Gemm g{(const pg8::bf16_t*)(args.ws + WS_HN), (const pg8::bf16_t*)(args.ws + WS_W1T), T, NBF, D}; pg8::StaticOrder SB; SB.init(T, NBF, F.G, bx);
          pg8::EpiBf16<0> E{(pg8::bf16_t*)(args.ws + WS_PROJ), NPROJ, nullptr, 0, 0, 1.f};
          pg8::Gemm g8{(const pg8::bf16_t*)(args.ws + WS_HN8), (const pg8::bf16_t*)(args.ws + WS_WQ8), T, 3072, D / 2}; pg8::StaticOrder S8; S8.init(T, 3072, F.G, bx);
          pg8::EpiBf16<0> E8{(pg8::bf16_t*)(args.ws + WS_PROJ) + 5120, NPROJ, nullptr, 0, 0, 1.f};
          const int nb16 = (T / 256) * (NBF / 256), n8 = (T / 256) * (3072 / 256);
          const int rb = (nb16 + F.G - 1) / F.G, r8 = (n8 + F.G - 1) / F.G, nr = rb + r8;
          const int ntile_all = (NT_ALL - NT_QKV - bx + F.G - 1) / F.G;
          const int ntile = (ntile_all * P1_SHARE + 99) / 100;
          const int per = (ntile + nr - 1) / nr; int tdone = 0; const bool conv_first = (bx & 1) != 0;
#pragma unroll 1
          for (int rr = 0; rr <= nr; ++rr) {
              { int want = (rr == nr) ? ntile : (conv_first ? rr + 1 : rr) * per; want = want < ntile ? want : ntile;
                if (want > tdone) { moe_weight_tiles(args, F, NT_QKV + bx + tdone * F.G, NT_QKV + bx + (want - 1) * F.G + 1); tdone = want; } }
              if (rr == nr) break;
              if (rr < rb) { pg8::OneUnit S1{SB, rr}; pg8::gemm_phase<pg8::EpiBf16<0>, pg8::OneUnit, true, true>(F.lds + RING_OFF, g, S1, E); }
              else { pg8::OneUnit S1{S8, rr - rb}; pg8::gemm_phase8<pg8::EpiBf16<0>, pg8::OneUnit, true, true, true>(F.lds + RING_OFF, g8, S1, E8, 121, 127); }
          } }
#else
        pg8::Gemm g{(const pg8::bf16_t*)(args.ws + WS_HN), (const pg8::bf16_t*)(args.ws + WS_W1T), T, NBF, D}; pg8::StaticOrder S; S.init(T, NBF, split ? 192 : F.G, split ? (bx >> 5) * 24 + (bx & 31) : bx);
        pg8::EpiBf16<0> E{(pg8::bf16_t*)(args.ws + WS_PROJ), NPROJ, nullptr, 0, 0, 1.f};
        pg8::gemm_phase<pg8::EpiBf16<0>, pg8::StaticOrder, true, true>(F.lds + RING_OFF, g, S, E);
#if MOE_FP8
        { pg8::Gemm g8{(const pg8::bf16_t*)(args.ws + WS_HN8), (const pg8::bf16_t*)(args.ws + WS_WQ8), T, 3072, D / 2}; pg8::StaticOrder S8; S8.init(T, 3072, F.G, bx);
          pg8::EpiBf16<0> E8{(pg8::bf16_t*)(args.ws + WS_PROJ) + 5120, NPROJ, nullptr, 0, 0, 1.f};
          pg8::gemm_phase8<pg8::EpiBf16<0>, pg8::StaticOrder, true, true, true>(F.lds + RING_OFF, g8, S8, E8, 121, 127); }
#endif
#endif
        }
        SEAM(1);
    }
    if (IN(2)) { p2_postproj(args, F); SEAM(2); }
    if (IN(3)) { attn_mfma(args, F); ssd_c1(args, F); SEAM(3); }
    if (IN(4)) { ssd_c2(args, F); attn_combine(args, F); SEAM(4); }
    if (IN(5)) {
#if C3_FLASH
        ssd_c3f(args, F);
#else
        ssd_c3(args, F);
#endif
        SEAM(5); }
    if (IN(6)) {
        pg8::Gemm g{(const pg8::bf16_t*)(args.ws + WS_MIX), (const pg8::bf16_t*)(args.ws + WS_WOT), T, D, DMIX}; pg8::StaticOrder S; S.init(T, D, F.G, (int)blockIdx.x);
        pg8::EpiResF32 E{(const float*)args.in[0], args.out, D};
#if MOE_FP8 && P1_INTERLEAVE
        { const int bx = (int)blockIdx.x; const int ntile_all = (NT_ALL - NT_QKV - bx + F.G - 1) / F.G, t0c = (ntile_all * P1_SHARE + 99) / 100, ntile = ntile_all - t0c;
          const int nu = ((T / 256) * (D / 256) + F.G - 1) / F.G; const int per = (ntile + nu - 1) / (nu > 0 ? nu : 1); int tdone = 0; const bool conv_first = (bx & 1) == 0;
#pragma unroll 1
          for (int rr = 0; rr <= nu; ++rr) {
              { int want = (rr == nu) ? ntile : (conv_first ? rr + 1 : rr) * per; want = want < ntile ? want : ntile;
                if (want > tdone) { moe_weight_tiles(args, F, NT_QKV + bx + (t0c + tdone) * F.G, NT_QKV + bx + (t0c + want - 1) * F.G + 1); tdone = want; } }
              if (rr == nu) break;
              pg8::OneUnit S1{S, rr}; pg8::gemm_phase<pg8::EpiResF32, pg8::OneUnit, true, true>(F.lds + RING_OFF, g, S1, E);
          } }
#else
        pg8::gemm_phase<pg8::EpiResF32, pg8::StaticOrder, true, true>(F.lds + RING_OFF, g, S, E);
#endif
        SEAM(6);
    }
    if (IN(7)) { REPLOOP(7) { REPBAR(); p7_router(args, F); } SEAM(7); }
    if (IN(8)) { p8_gather(args, F); SEAM(8); }
    if (IN(9)) {
        const int ntiles = moe_tiles_to_lds(args, F);
#if MOE_FP8
        pg8::Gemm g{(const pg8::bf16_t*)(args.ws + WS_XG), (const pg8::bf16_t*)(args.ws + WS_WGU), 0, 2048, D / 2};
        pg8::MoeOrder S{(const LAS int*)(F.lds + TAB_OFF), ntiles, 8, F.G, moe_slot(F), (size_t)2048 * D};
        pg8::EpiSwiglu8 E{(unsigned char*)(args.ws + WS_HID), DEXP, (const float*)(args.ws + WS_ROWRS)};
        pg8::gemm_phase8<pg8::EpiSwiglu8, pg8::MoeOrder, true, true, true>(F.lds + RING_OFF, g, S, E, 121, 127);
#else
        pg8::Gemm g{(const pg8::bf16_t*)(args.ws + WS_XG), (const pg8::bf16_t*)(args.ws + WS_WGU), 0, 2048, D};
        pg8::MoeOrder S{(const LAS int*)(F.lds + TAB_OFF), ntiles, 8, F.G, (int)blockIdx.x, (size_t)2048 * D * 2};
        pg8::EpiSwiglu E{(pg8::bf16_t*)(args.ws + WS_HID), DEXP};
        pg8::gemm_phase<pg8::EpiSwiglu, pg8::MoeOrder, true, true>(F.lds + RING_OFF, g, S, E);
#endif
        SEAM(9);
    }
    if (IN(10)) {
        const int ntiles = moe_tiles_to_lds(args, F);
#if MOE_FP8
        pg8::Gemm g{(const pg8::bf16_t*)(args.ws + WS_HID), (const pg8::bf16_t*)(args.ws + WS_WD), 0, D, DEXP / 2};
        pg8::MoeOrder S{(const LAS int*)(F.lds + TAB_OFF), ntiles, 8, F.G, moe_slot(F), (size_t)D * DEXP};
        pg8::EpiFp8 E{(unsigned char*)(args.ws + WS_Y), D, 8.f};
        pg8::gemm_phase8<pg8::EpiFp8, pg8::MoeOrder, true, true, true>(F.lds + RING_OFF, g, S, E, 121, 125);
#else
        pg8::Gemm g{(const pg8::bf16_t*)(args.ws + WS_HID), (const pg8::bf16_t*)(args.ws + WS_WD), 0, D, DEXP};
        pg8::MoeOrder S{(const LAS int*)(F.lds + TAB_OFF), ntiles, 8, F.G, (int)blockIdx.x, (size_t)D * DEXP * 2};
        pg8::EpiBf16<0> E{(pg8::bf16_t*)(args.ws + WS_Y), D, nullptr, 0, 0, 1.f};
        pg8::gemm_phase<pg8::EpiBf16<0>, pg8::MoeOrder, true, true>(F.lds + RING_OFF, g, S, E);
#endif
        SEAM(10);
    }
    if (IN(11)) { p11_combine(args, F); }
#undef IN
#undef SEAM
}

#ifndef ONE_LAUNCH
#define ONE_LAUNCH 1
#endif
extern "C" void kernel_launch(void* const* d_in, const int* in_sizes, int n_in, void* d_out, int out_size, void* d_ws, size_t ws_size, hipStream_t stream) {
    static int grid = 0;
    if (grid == 0) {
        if (n_in != 21 || out_size != T * D || ws_size < WS_END) { fprintf(stderr, "kernel_launch: unexpected shapes (n_in %d, out %d, ws %zu)\n", n_in, out_size, ws_size); grid = -1; return; }
        int dev = 0, cus = 0, per_cu = 0;
        if (hipGetDevice(&dev) != hipSuccess || hipDeviceGetAttribute(&cus, hipDeviceAttributeMultiprocessorCount, dev) != hipSuccess) { grid = -1; return; }
        if (hipFuncSetAttribute((const void*)hymba_fwd, hipFuncAttributeMaxDynamicSharedMemorySize, LDS_BYTES) != hipSuccess) { fprintf(stderr, "kernel_launch: hipFuncSetAttribute failed\n"); grid = -1; return; }
        if (hipOccupancyMaxActiveBlocksPerMultiprocessor(&per_cu, (const void*)hymba_fwd, NWAVES * 64, LDS_BYTES) != hipSuccess || per_cu < 1) { fprintf(stderr, "kernel_launch: occupancy query says %d\n", per_cu); }
        (void)hipGetLastError();
        grid = cus;
    }
    if (grid < 0) return;
    if (hipMemsetAsync((char*)d_ws + WS_CTL, 0, CTL_ZERO_BYTES, stream) != hipSuccess) return;
    Args a{};
    for (int i = 0; i < 21; ++i) a.in[i] = d_in[i];
    a.out = (float*)d_out; a.ws = (unsigned char*)d_ws;
#if ONE_LAUNCH
    a.ph_lo = 0; a.ph_hi = NPHASE;
    hipLaunchKernelGGL(hymba_fwd, dim3(grid), dim3(NWAVES * 64), LDS_BYTES, stream, a);
#else
    for (int ph = 0; ph < NPHASE; ++ph) { a.ph_lo = ph; a.ph_hi = ph + 1; hipLaunchKernelGGL(hymba_fwd, dim3(grid), dim3(NWAVES * 64), LDS_BYTES, stream, a); }
#endif
}
```
